# Optimizing an MI355X kernel written in HIP

```python
import math
import jax, jax.numpy as jnp
from jax import lax
import numpy as np

D_MODEL = 1024
BATCH = 4
SEQ = 4096
DEPTH = 4

N_A = DEPTH // 2
N_B = DEPTH - N_A
POOL_WINDOWS = (2, 4, 8, 16)
POOL_GROUP = D_MODEL // len(POOL_WINDOWS)
N_HEADS = 16
HEAD_DIM = 64
N_KV_GROUPS = 4
HEADS_PER_GROUP = N_HEADS // N_KV_GROUPS
CMP_STRIDE = 16
CMP_LEN = 2 * CMP_STRIDE
CMP_HIDDEN = 128
SLC_BLOCK = 64
N_SELECT = 16
WINDOW = 512
Q_BLOCK = 64
N_BRANCH = 3
ROPE_THETA = 500000.0
ROT_DIM = HEAD_DIM // 4
D_FF = 2816
CONV_W = 3
PLE_DIM = 256

EPS = 1e-6
NEG = -1e30
FORCE_SCORE = 1e4

kernel_name = "hybrid_pool_nsa_yoco_trunk"


def rmsnorm(x, g):
    xf = x.astype(jnp.float32)
    y = xf * lax.rsqrt(jnp.mean(xf * xf, axis=-1, keepdims=True) + EPS) * g.astype(jnp.float32)
    return y.astype(x.dtype)


def rope_tables(pos):
    inv_freq = ROPE_THETA ** (-jnp.arange(0, ROT_DIM, 2, dtype=jnp.float32) / ROT_DIM)
    ang = pos.astype(jnp.float32)[..., None] * inv_freq
    return jnp.cos(ang), jnp.sin(ang)


def rope(x, cos, sin):
    xf = x.astype(jnp.float32)
    half = ROT_DIM // 2
    x1, x2, xp = xf[..., :half], xf[..., half:ROT_DIM], xf[..., ROT_DIM:]
    out = jnp.concatenate([x1 * cos - x2 * sin, x2 * cos + x1 * sin, xp], axis=-1)
    return out.astype(x.dtype)


def masked_softmax(s, mask):
    s = jnp.where(mask, s, NEG)
    m = jnp.max(s, axis=-1, keepdims=True)
    e = jnp.where(mask, jnp.exp(s - m), 0.0)
    return e / jnp.maximum(jnp.sum(e, axis=-1, keepdims=True), 1e-30)


def pool_mixer(h, w, scale):
    B, S, D = h.shape
    c = jnp.cumsum(h.astype(jnp.float32), axis=1)
    c = jnp.pad(c, ((0, 0), (1, 0), (0, 0)))
    t = jnp.arange(S)
    outs = []
    for gi, win in enumerate(POOL_WINDOWS):
        sl = slice(gi * POOL_GROUP, (gi + 1) * POOL_GROUP)
        cg = c[..., sl]
        lo = jnp.maximum(t + 1 - win, 0)
        cnt = jnp.minimum(t + 1, win).astype(jnp.float32)
        avg = (cg[:, t + 1] - cg[:, lo]) / cnt[:, None]
        u = (avg - h[..., sl].astype(jnp.float32)).astype(h.dtype)
        outs.append(jnp.einsum('bsc,cd->bsd', u, w[gi]))
    return jnp.concatenate(outs, axis=-1) * scale


def conv_ffn(h, w_up, conv_w, conv_b, w_down):
    S = h.shape[1]
    u = h @ w_up
    up = jnp.pad(u, ((0, 0), (CONV_W - 1, 0), (0, 0)))
    u = sum(conv_w[j] * up[:, j:j + S] for j in range(CONV_W)) + conv_b
    a, g = u[..., :D_FF], u[..., D_FF:]
    return (jax.nn.silu(g) * a) @ w_down


def compress(blocks, pos_emb, w1, w2):
    z = blocks + pos_emb
    z = z.reshape(z.shape[:3] + (CMP_LEN * HEAD_DIM,))
    return jax.nn.gelu(z @ w1) @ w2


def nsa_shared_kv(x, positions, norm_kv, w_kv, cmp_pos_k, cmp_w1_k, cmp_w2_k, cmp_pos_v, cmp_w1_v, cmp_w2_v):
    B, S, _ = x.shape
    h = rmsnorm(x, norm_kv)
    kv = (h @ w_kv).reshape(B, S, 2 * N_BRANCH, N_KV_GROUPS, HEAD_DIM).transpose(2, 0, 3, 1, 4)
    k_c, v_c, k_s, v_s, k_w, v_w = [kv[i] for i in range(2 * N_BRANCH)]
    cos, sin = rope_tables(positions)
    k_s = rope(k_s, cos[:, None], sin[:, None])
    k_w = rope(k_w, cos[:, None], sin[:, None])
    n_chunk = S // CMP_STRIDE
    n_cmp = n_chunk - 1
    def blocks_of(z):
        ch = z.reshape(B, N_KV_GROUPS, n_chunk, CMP_STRIDE, HEAD_DIM)
        return jnp.concatenate([ch[:, :, :-1], ch[:, :, 1:]], axis=3)
    kc = compress(blocks_of(k_c), cmp_pos_k, cmp_w1_k, cmp_w2_k)
    vc = compress(blocks_of(v_c), cmp_pos_v, cmp_w1_v, cmp_w2_v)
    end_idx = CMP_STRIDE * jnp.arange(n_cmp) + CMP_LEN - 1
    cos_c, sin_c = rope_tables(positions[:, end_idx])
    kc = rope(kc, cos_c[:, None], sin_c[:, None])
    n_slc = S // SLC_BLOCK
    ks_blk = k_s.reshape(B, N_KV_GROUPS, n_slc, SLC_BLOCK, HEAD_DIM)
    vs_blk = v_s.reshape(B, N_KV_GROUPS, n_slc, SLC_BLOCK, HEAD_DIM)
    pad = ((0, 0), (0, 0), (WINDOW, 0), (0, 0))
    kw_pad, vw_pad = jnp.pad(k_w, pad), jnp.pad(v_w, pad)
    return (kc, vc, ks_blk, vs_blk, kw_pad, vw_pad)


def nsa_attention(h, w_in, w_out, cos, sin, kv):
    kc, vc, ks_blk, vs_blk, kw_pad, vw_pad = kv
    B, S, _ = h.shape
    n_cmp = kc.shape[2]
    n_slc = ks_blk.shape[2]
    n_top = min(N_SELECT, n_slc)
    scale = HEAD_DIM ** -0.5
    proj = h @ w_in
    q = proj[..., :N_HEADS * HEAD_DIM].reshape(B, S, N_HEADS, HEAD_DIM)
    q = rope(q, cos[:, :, None], sin[:, :, None])
    q = q.reshape(B, S, N_KV_GROUPS, HEADS_PER_GROUP, HEAD_DIM).transpose(0, 2, 3, 1, 4)
    gates = jax.nn.sigmoid(proj[..., N_HEADS * HEAD_DIM:].astype(jnp.float32))
    gates = gates.reshape(B, S, N_KV_GROUPS, HEADS_PER_GROUP, N_BRANCH).transpose(0, 2, 3, 1, 4)

    c_idx = jnp.arange(n_cmp)
    c_end = CMP_STRIDE * c_idx + CMP_LEN - 1
    blk = jnp.arange(n_slc)
    c_start = CMP_STRIDE * c_idx
    overlap = ((c_start[:, None] < (blk[None] + 1) * SLC_BLOCK)
               & (c_start[:, None] + CMP_LEN > blk[None] * SLC_BLOCK)).astype(jnp.float32)
    gather = jax.vmap(jax.vmap(lambda kb, ix: kb[ix]))

    def block_fn(s):
        t = s + jnp.arange(Q_BLOCK)
        qb = lax.dynamic_slice_in_dim(q, s, Q_BLOCK, axis=3)
        gb = lax.dynamic_slice_in_dim(gates, s, Q_BLOCK, axis=3)
        sc = jnp.einsum('bghqd,bgcd->bghqc', qb, kc).astype(jnp.float32) * scale
        p_c = masked_softmax(sc, c_end[None, :] <= t[:, None])
        o_c = jnp.einsum('bghqc,bgcd->bghqd', p_c.astype(vc.dtype), vc)
        imp = jnp.einsum('bghqc,cn->bgqn', p_c, overlap)
        cur = t // SLC_BLOCK
        forced = (blk[None] == 0) | (blk[None] == cur[:, None]) | (blk[None] == cur[:, None] - 1)
        valid = blk[None] * SLC_BLOCK <= t[:, None]
        score = jnp.where(valid, jnp.where(forced, FORCE_SCORE, imp), NEG)
        vals, idx = lax.top_k(score, n_top)
        ok = vals > 0.5 * NEG
        ks_g = gather(ks_blk, idx).reshape(B, N_KV_GROUPS, Q_BLOCK, n_top * SLC_BLOCK, HEAD_DIM)
        vs_g = gather(vs_blk, idx).reshape(B, N_KV_GROUPS, Q_BLOCK, n_top * SLC_BLOCK, HEAD_DIM)
        kpos = idx[..., None] * SLC_BLOCK + jnp.arange(SLC_BLOCK)
        mask_s = (ok[..., None] & (kpos <= t[:, None, None])).reshape(B, N_KV_GROUPS, Q_BLOCK, n_top * SLC_BLOCK)
        ss = jnp.einsum('bghqd,bgqkd->bghqk', qb, ks_g).astype(jnp.float32) * scale
        p_s = masked_softmax(ss, mask_s[:, :, None])
        o_s = jnp.einsum('bghqk,bgqkd->bghqd', p_s.astype(vs_g.dtype), vs_g)
        kw = lax.dynamic_slice_in_dim(kw_pad, s, WINDOW + Q_BLOCK, axis=2)
        vw = lax.dynamic_slice_in_dim(vw_pad, s, WINDOW + Q_BLOCK, axis=2)
        kpos_w = s - WINDOW + jnp.arange(WINDOW + Q_BLOCK)
        diff = t[:, None] - kpos_w[None]
        mask_w = (diff >= 0) & (diff < WINDOW) & (kpos_w[None] >= 0)
        sw = jnp.einsum('bghqd,bgkd->bghqk', qb, kw).astype(jnp.float32) * scale
        p_w = masked_softmax(sw, mask_w)
        o_w = jnp.einsum('bghqk,bgkd->bghqd', p_w.astype(vw.dtype), vw)
        out = (gb[..., 0:1] * o_c.astype(jnp.float32) + gb[..., 1:2] * o_s.astype(jnp.float32)
               + gb[..., 2:3] * o_w.astype(jnp.float32))
        return out.astype(h.dtype)

    starts = jnp.arange(S // Q_BLOCK) * Q_BLOCK
    o = lax.map(block_fn, starts)
    o = o.transpose(1, 0, 4, 2, 3, 5).reshape(B, S, N_HEADS * HEAD_DIM)
    return o @ w_out


def setup_inputs(seed: int = 0) -> dict:
    key = jax.random.key(seed)
    ks = iter(jax.random.split(key, 40))
    f32 = jnp.float32
    def w(shape, fan):
        return jax.random.normal(next(ks), shape, f32) * (fan ** -0.5)
    def gain(shape):
        return 1.0 + 0.05 * jax.random.normal(next(ks), shape, f32)
    def small(shape, s=0.02):
        return s * jax.random.normal(next(ks), shape, f32)
    q_cols = N_HEADS * HEAD_DIM + N_HEADS * N_BRANCH
    return {
        "x": jax.random.normal(next(ks), (BATCH, SEQ, D_MODEL), f32),
        "p": jax.random.normal(next(ks), (DEPTH, BATCH, SEQ, PLE_DIM), f32),
        "positions": jnp.broadcast_to(jnp.arange(SEQ, dtype=jnp.int32), (BATCH, SEQ)),
        "norm_mix": gain((DEPTH, D_MODEL)),
        "pool_w": w((N_A, len(POOL_WINDOWS), POOL_GROUP, POOL_GROUP), POOL_GROUP),
        "pool_scale": gain((N_A, D_MODEL)),
        "norm_kv": gain((D_MODEL,)),
        "w_kv": w((D_MODEL, 2 * N_BRANCH * N_KV_GROUPS * HEAD_DIM), D_MODEL),
        "cmp_pos_k": small((CMP_LEN, HEAD_DIM), 0.1),
        "cmp_w1_k": w((CMP_LEN * HEAD_DIM, CMP_HIDDEN), CMP_LEN * HEAD_DIM),
        "cmp_w2_k": w((CMP_HIDDEN, HEAD_DIM), CMP_HIDDEN),
        "cmp_pos_v": small((CMP_LEN, HEAD_DIM), 0.1),
        "cmp_w1_v": w((CMP_LEN * HEAD_DIM, CMP_HIDDEN), CMP_LEN * HEAD_DIM),
        "cmp_w2_v": w((CMP_HIDDEN, HEAD_DIM), CMP_HIDDEN),
        "w_in_b": w((N_B, D_MODEL, q_cols), D_MODEL),
        "w_out_b": w((N_B, N_HEADS * HEAD_DIM, D_MODEL), N_HEADS * HEAD_DIM),
        "norm_ffn": gain((DEPTH, D_MODEL)),
        "ffn_up": w((DEPTH, D_MODEL, 2 * D_FF), D_MODEL),
        "ffn_conv": w((DEPTH, CONV_W, 2 * D_FF), CONV_W),
        "ffn_conv_b": small((DEPTH, 2 * D_FF)),
        "ffn_down": w((DEPTH, D_FF, D_MODEL), D_FF),
        "norm_ple": gain((DEPTH, D_MODEL)),
        "ple_gate": w((DEPTH, D_MODEL, D_MODEL), D_MODEL),
        "ple_proj": w((DEPTH, PLE_DIM, D_MODEL), PLE_DIM),
        "norm_final": gain((D_MODEL,)),
    }


def reference(x, p, positions, norm_mix, pool_w, pool_scale, norm_kv, w_kv,
              cmp_pos_k, cmp_w1_k, cmp_w2_k, cmp_pos_v, cmp_w1_v, cmp_w2_v,
              w_in_b, w_out_b, norm_ffn, ffn_up, ffn_conv, ffn_conv_b, ffn_down,
              norm_ple, ple_gate, ple_proj, norm_final):
    cos, sin = rope_tables(positions)
    kv = None
    for i in range(DEPTH):
        if i < N_A:
            x = x + pool_mixer(rmsnorm(x, norm_mix[i]), pool_w[i], pool_scale[i])
        else:
            if i == N_A:
                kv = nsa_shared_kv(x, positions, norm_kv, w_kv, cmp_pos_k, cmp_w1_k, cmp_w2_k,
                                   cmp_pos_v, cmp_w1_v, cmp_w2_v)
            j = i - N_A
            x = x + nsa_attention(rmsnorm(x, norm_mix[i]), w_in_b[j], w_out_b[j], cos, sin, kv)
        x = x + conv_ffn(rmsnorm(x, norm_ffn[i]), ffn_up[i], ffn_conv[i], ffn_conv_b[i], ffn_down[i])
        gate = jax.nn.sigmoid(rmsnorm(x, norm_ple[i]) @ ple_gate[i])
        x = x + gate * (p[i] @ ple_proj[i])
    return rmsnorm(x, norm_final)
```

```cpp
#include <hip/hip_runtime.h>
#include <hip/hip_bf16.h>
#include <cstdio>
#include <cstdint>
#include <cmath>

#ifndef MK_PER_PHASE
#define MK_PER_PHASE 1
#endif

namespace pg8 {
#define PG8_LAS __attribute__((address_space(3)))
typedef unsigned short bf16_t;
typedef short bf16x8 __attribute__((ext_vector_type(8)));
typedef float f32x4 __attribute__((ext_vector_type(4)));
typedef unsigned u32x4 __attribute__((ext_vector_type(4)));
typedef unsigned u32x2 __attribute__((ext_vector_type(2)));
constexpr int BM = 256, BK = 64, HALF = 128, HTB = HALF * BK * 2, STAGE_BYTES = 8 * HTB, NXCD = 8, WGM = 8;

__host__ __device__ __forceinline__ int lds_byte(int r, int c) { const int st = (r >> 4) * 2 + (c >> 5), rr = r & 15, cc = c & 31, ob = rr * 64 + cc * 2; return st * 1024 + (ob ^ (((ob >> 9) & 1) << 5)); }
__host__ __device__ __forceinline__ void stage_rc(int b, int& R, int& C) { const int st = b / 1024, sb = b % 1024, swz = sb ^ (((sb >> 9) & 1) << 5); R = (st >> 1) * 16 + swz / 64; C = (st & 1) * 32 + (swz % 64) / 2; }
__host__ __device__ __forceinline__ int perm32(int rho) { const int n = rho >> 4, i = rho & 15; return 8 * (i >> 2) + 4 * n + (i & 3); }

struct Unit { int pm, pn; const char* a; const char* b; };
struct Gemm { int lda, ldb; int kstepA, kstepB; int nt; };

__device__ __forceinline__ bool tile_order(int nM, int nN, int G, int c, int i, int& pm, int& pn) {
    const int nwg = nM * nN; const long L = (long)i * G + c; if (L >= nwg) return false;
    int wgid = (int)L; { const int q = nwg / NXCD, r = nwg % NXCD, xcd = wgid % NXCD, off = wgid / NXCD; wgid = (xcd < r ? xcd * (q + 1) : r * (q + 1) + (xcd - r) * q) + off; }
    const int nig = WGM * nN, gid = wgid / nig, fm = gid * WGM, gsz = (nM - fm) < WGM ? (nM - fm) : WGM;
    pm = fm + ((wgid % nig) % gsz); pn = (wgid % nig) / gsz; return true;
}
struct GridOrder {
    int nM, nN, G, c; const char* A; const char* B; size_t a_tile, a_pn, b_tile; int pm_div; size_t b_pm;
    __device__ __forceinline__ bool next(int i, Unit& u) const {
        int pm, pn; if (!tile_order(nM, nN, G, c, i, pm, pn)) return false;
        u.pm = pm; u.pn = pn; u.a = A + (size_t)pm * a_tile + (size_t)pn * a_pn; u.b = B + (size_t)pn * b_tile + (size_t)(pm / pm_div) * b_pm; return true; }
    __device__ __forceinline__ void a_ready(const Unit&) const {}
    __device__ __forceinline__ void done(const Unit&) const {}
};
struct OneUnit { Unit u; bool valid;
    __device__ __forceinline__ bool next(int i, Unit& o) const { if (i != 0 || !valid) return false; o = u; return true; }
    __device__ __forceinline__ void a_ready(const Unit&) const {}
    __device__ __forceinline__ void done(const Unit&) const {}
};
__device__ __forceinline__ unsigned cvt_pk_bf16(float lo, float hi) { unsigned r; asm volatile("v_cvt_pk_bf16_f32 %0, %1, %2" : "=v"(r) : "v"(lo), "v"(hi)); return r; }
__device__ __forceinline__ float bf_lo(unsigned w) { return __uint_as_float(w << 16); }
__device__ __forceinline__ float bf_hi(unsigned w) { return __uint_as_float(w & 0xffff0000u); }
__device__ __forceinline__ float sigmoidf_(float v) { return 1.0f / (1.0f + __expf(-v)); }

template <class Epi, class Sched, bool ALIGN_EPI = false, bool SP2 = false>
__device__ __forceinline__ void gemm_phase(PG8_LAS unsigned char* lds, const Gemm g, const Sched& S, const Epi& E, const int tid) {
    const int wid = __builtin_amdgcn_readfirstlane(tid >> 6), lane = tid & 63, wr = wid >> 2, wc = wid & 3, fr = lane & 15, fq = lane >> 4;
    const int nt = g.nt;
    unsigned voffA[2], voffB[2];
#pragma unroll
    for (int i = 0; i < 2; ++i) { int R, C; stage_rc(tid * 16 + i * 8192, R, C); const int Rb = Epi::PERM ? ((R & ~31) + perm32(R & 31)) : R;
        voffA[i] = (unsigned)(R * g.lda + C) * 2u; voffB[i] = (unsigned)(Rb * g.ldb + C) * 2u; }
    const unsigned kstepA = (unsigned)g.kstepA, kstepB = (unsigned)g.kstepB;
    const unsigned hstepA = (unsigned)(HALF * g.lda * 2), hstepB = (unsigned)(HALF * g.ldb * 2);
    const unsigned ldsw = (unsigned)wid * 1024u;
    const int aoff = lds_byte(wr * 64 + fr, fq * 8), boff = lds_byte(wc * 32 + fr, fq * 8);
#define PG8_SA(b, h) (((b) * 2 + (h)) * HTB)
#define PG8_SB(b, h) ((4 + (b) * 2 + (h)) * HTB)
#define PG8_STAGE(bufoff, gbase, voff) do { _Pragma("unroll") for (int _i = 0; _i < 2; ++_i) \
        __builtin_amdgcn_global_load_lds((const unsigned*)((const char*)(gbase) + (voff)[_i]), (PG8_LAS unsigned*)(lds + (bufoff) + ldsw + _i * 8192), 16, 0, 0); } while (0)
#define PG8_LDA(dst, b, h) do { _Pragma("unroll") for (int m = 0; m < 4; ++m) _Pragma("unroll") for (int k = 0; k < 2; ++k) dst[m][k] = *(const PG8_LAS bf16x8*)(lds + PG8_SA(b, h) + aoff + m * 2048 + k * 1024); } while (0)
#define PG8_LDB(dst, b, h) do { _Pragma("unroll") for (int n = 0; n < 2; ++n) _Pragma("unroll") for (int k = 0; k < 2; ++k) dst[n][k] = *(const PG8_LAS bf16x8*)(lds + PG8_SB(b, h) + boff + n * 2048 + k * 1024); } while (0)
#define PG8_MMA(ai, bj, At, Bt) do { __builtin_amdgcn_s_setprio(1); _Pragma("unroll") for (int m = 0; m < 4; ++m) _Pragma("unroll") for (int n = 0; n < 2; ++n) _Pragma("unroll") for (int k = 0; k < 2; ++k) \
        acc[ai][bj][m][n] = __builtin_amdgcn_mfma_f32_16x16x32_bf16(Bt[n][k], At[m][k], acc[ai][bj][m][n], 0, 0, 0); __builtin_amdgcn_s_setprio(0); } while (0)
#define PG8_WAIT_V(n) asm volatile("s_waitcnt vmcnt(" #n ")" ::: "memory")
#define PG8_WAIT_L(n) asm volatile("s_waitcnt lgkmcnt(" #n ")" ::: "memory")
#define PG8_BAR __builtin_amdgcn_s_barrier()
#define PG8_SCHED __builtin_amdgcn_sched_barrier(0)
    Unit cur, nxt; int ui = 0;
    if (!S.next(0, cur)) return;
    f32x4 acc[2][2][4][2];
#pragma unroll
    for (int a = 0; a < 2; ++a)
#pragma unroll
        for (int b = 0; b < 2; ++b)
#pragma unroll
            for (int m = 0; m < 4; ++m)
#pragma unroll
                for (int n = 0; n < 2; ++n) acc[a][b][m][n] = (f32x4){0.f, 0.f, 0.f, 0.f};
    bf16x8 At[4][2], B0[2][2], B1[2][2];
    const char* cA = cur.a; const char* cB = cur.b;
    S.a_ready(cur);
    if constexpr (SP2) {
        PG8_STAGE(PG8_SB(0, 0), cB, voffB); PG8_STAGE(PG8_SB(0, 1), cB + hstepB, voffB); PG8_STAGE(PG8_SA(0, 0), cA, voffA); PG8_STAGE(PG8_SA(0, 1), cA + hstepA, voffA);
        if (wr == 1) PG8_BAR;
        PG8_WAIT_V(2); PG8_BAR;
        PG8_STAGE(PG8_SB(1, 0), cB + kstepB, voffB); PG8_STAGE(PG8_SA(1, 0), cA + kstepA, voffA); PG8_STAGE(PG8_SB(1, 1), cB + hstepB + kstepB, voffB);
        PG8_WAIT_V(6); PG8_BAR;
    } else {
        PG8_STAGE(PG8_SB(0, 0), cB, voffB); PG8_STAGE(PG8_SA(0, 0), cA, voffA); PG8_STAGE(PG8_SB(0, 1), cB + hstepB, voffB); PG8_STAGE(PG8_SA(0, 1), cA + hstepA, voffA);
        if (wr == 1) PG8_BAR;
        PG8_WAIT_V(4); PG8_BAR;
        PG8_STAGE(PG8_SB(1, 0), cB + kstepB, voffB); PG8_STAGE(PG8_SA(1, 0), cA + kstepA, voffA); PG8_STAGE(PG8_SB(1, 1), cB + hstepB + kstepB, voffB);
        PG8_WAIT_V(6); PG8_BAR;
    }
    for (;;) {
        const bool has_next = S.next(ui + 1, nxt);
        const char* nA = has_next ? nxt.a : cA; const char* nB = has_next ? nxt.b : cB;
        for (int t = 0; t < nt; t += 2) {
            const bool last = (t == nt - 2);
            const char* a1 = cA + (size_t)((unsigned)(t + 1) * kstepA);
            const char* a2 = last ? nA : cA + (size_t)((unsigned)(t + 2) * kstepA); const char* b2 = last ? nB : cB + (size_t)((unsigned)(t + 2) * kstepB);
            const char* a3 = a2 + kstepA; const char* b3 = b2 + kstepB;
            if (last && has_next) S.a_ready(nxt);
            if constexpr (SP2) {
            PG8_LDB(B0, 0, 0); PG8_LDB(B1, 0, 1); PG8_SCHED; PG8_LDA(At, 0, 0); PG8_STAGE(PG8_SA(1, 1), a1 + hstepA, voffA);
            PG8_WAIT_V(8); PG8_WAIT_L(0); PG8_BAR; PG8_MMA(0, 0, At, B0); PG8_MMA(0, 1, At, B1); PG8_BAR; PG8_SCHED;
            PG8_LDA(At, 0, 1); PG8_STAGE(PG8_SB(0, 0), b2, voffB); PG8_STAGE(PG8_SB(0, 1), b2 + hstepB, voffB); PG8_STAGE(PG8_SA(0, 0), a2, voffA);
            PG8_WAIT_V(8); PG8_WAIT_L(0); PG8_BAR; PG8_MMA(1, 0, At, B0); PG8_MMA(1, 1, At, B1); PG8_BAR; PG8_SCHED;
            PG8_LDB(B0, 1, 0); PG8_LDB(B1, 1, 1); PG8_SCHED; PG8_LDA(At, 1, 0); PG8_STAGE(PG8_SA(0, 1), a2 + hstepA, voffA);
            PG8_WAIT_V(8); PG8_WAIT_L(0); PG8_BAR; PG8_MMA(0, 0, At, B0); PG8_MMA(0, 1, At, B1); PG8_BAR; PG8_SCHED;
            PG8_LDA(At, 1, 1); PG8_STAGE(PG8_SB(1, 0), b3, voffB); PG8_STAGE(PG8_SB(1, 1), b3 + hstepB, voffB); PG8_STAGE(PG8_SA(1, 0), a3, voffA);
            PG8_WAIT_V(8); PG8_WAIT_L(0); PG8_BAR; PG8_MMA(1, 0, At, B0); PG8_MMA(1, 1, At, B1); PG8_BAR; PG8_SCHED;
            } else {
            PG8_LDB(B0, 0, 0); PG8_SCHED; PG8_LDA(At, 0, 0); PG8_STAGE(PG8_SA(1, 1), a1 + hstepA, voffA);
            PG8_WAIT_L(8); PG8_BAR; PG8_WAIT_L(0); PG8_MMA(0, 0, At, B0); PG8_BAR; PG8_SCHED;
            PG8_LDB(B1, 0, 1); PG8_STAGE(PG8_SB(0, 0), b2, voffB);
            PG8_BAR; PG8_WAIT_L(0); PG8_MMA(0, 1, At, B1); PG8_BAR;
            PG8_LDA(At, 0, 1); PG8_STAGE(PG8_SA(0, 0), a2, voffA);
            PG8_BAR; PG8_WAIT_L(0); PG8_MMA(1, 0, At, B0); PG8_BAR; PG8_SCHED;
            PG8_STAGE(PG8_SB(0, 1), b2 + hstepB, voffB);
            PG8_WAIT_V(6); PG8_BAR; PG8_MMA(1, 1, At, B1); PG8_BAR;
            PG8_LDB(B0, 1, 0); PG8_SCHED; PG8_LDA(At, 1, 0); PG8_STAGE(PG8_SA(0, 1), a2 + hstepA, voffA);
            PG8_WAIT_L(8); PG8_BAR; PG8_WAIT_L(0); PG8_MMA(0, 0, At, B0); PG8_BAR; PG8_SCHED;
            PG8_LDB(B1, 1, 1); PG8_STAGE(PG8_SB(1, 0), b3, voffB);
            PG8_BAR; PG8_WAIT_L(0); PG8_MMA(0, 1, At, B1); PG8_BAR;
            PG8_LDA(At, 1, 1); PG8_STAGE(PG8_SA(1, 0), a3, voffA);
            PG8_BAR; PG8_WAIT_L(0); PG8_MMA(1, 0, At, B0); PG8_BAR; PG8_SCHED;
            PG8_STAGE(PG8_SB(1, 1), b3 + hstepB, voffB);
            PG8_WAIT_V(6); PG8_BAR; PG8_MMA(1, 1, At, B1); PG8_BAR;
            }
        }
        if constexpr (ALIGN_EPI) { if (wr == 0) PG8_BAR; }
        if constexpr (!Epi::AFTER_DRAIN) { int z_e = 0; asm volatile("" : "+v"(z_e)); const int lane_e = (int)__builtin_amdgcn_mbcnt_hi(~0u, __builtin_amdgcn_mbcnt_lo(~0u, (unsigned)z_e)); const int fr_e = lane_e & 15, fq_e = lane_e >> 4; E(acc, cur, wr, wc, fr_e, fq_e); S.done(cur); }
        if (!has_next) break;
#pragma unroll
        for (int a = 0; a < 2; ++a)
#pragma unroll
            for (int b = 0; b < 2; ++b)
#pragma unroll
                for (int m = 0; m < 4; ++m)
#pragma unroll
                    for (int n = 0; n < 2; ++n) acc[a][b][m][n] = (f32x4){0.f, 0.f, 0.f, 0.f};
        cur = nxt; cA = nA; cB = nB; ++ui;
        if constexpr (ALIGN_EPI) { if (wr == 1) PG8_BAR; }
    }
    PG8_WAIT_V(0);
    if constexpr (!ALIGN_EPI) { if (wr == 0) PG8_BAR; }
    PG8_BAR;
    if constexpr (Epi::AFTER_DRAIN) { int z_e = 0; asm volatile("" : "+v"(z_e)); const int lane_e = (int)__builtin_amdgcn_mbcnt_hi(~0u, __builtin_amdgcn_mbcnt_lo(~0u, (unsigned)z_e)); const int fr_e = lane_e & 15, fq_e = lane_e >> 4; E.fused(acc, cur, wr, wc, fr_e, fq_e, lds, wid, lane_e); S.done(cur); }
#undef PG8_SA
#undef PG8_SB
#undef PG8_STAGE
#undef PG8_LDA
#undef PG8_LDB
#undef PG8_MMA
#undef PG8_WAIT_V
#undef PG8_WAIT_L
#undef PG8_BAR
#undef PG8_SCHED
}

}

constexpr int M = 16384, D = 1024, SEQ = 4096, NBATCH = 4, DEPTH = 4, FF = 2816, FF2 = 5632, PLE = 256;
constexpr int NKV = 1536, NQC = 1072;
constexpr float EPS = 1e-6f;
constexpr float QSCALE = 0.125f * 1.4426950408889634f;
constexpr int UPM = 254;
constexpr int NUPM = (M + UPM - 1) / UPM;
constexpr int TPITCH = 264;

#define GAS __attribute__((address_space(1)))
#define LAS __attribute__((address_space(3)))
typedef unsigned short bf16;
typedef float f32x4 __attribute__((ext_vector_type(4)));
typedef float f32x16 __attribute__((ext_vector_type(16)));
typedef short bf16x8 __attribute__((ext_vector_type(8)));
typedef short s16x4 __attribute__((ext_vector_type(4)));
typedef unsigned u32x4 __attribute__((ext_vector_type(4)));
typedef unsigned u32x2 __attribute__((ext_vector_type(2)));
using pg8::cvt_pk_bf16; using pg8::bf_lo; using pg8::bf_hi; using pg8::sigmoidf_;


template <int MASK> __device__ __forceinline__ float swz_xor(float v) { return __uint_as_float((unsigned)__builtin_amdgcn_ds_swizzle((int)__float_as_uint(v), 0x1F | (MASK << 10))); }
template <int MASK> __device__ __forceinline__ unsigned swz_xor_u(unsigned v) { return (unsigned)__builtin_amdgcn_ds_swizzle((int)v, 0x1F | (MASK << 10)); }
__device__ __forceinline__ float xor32_sum(float v) { auto rr = __builtin_amdgcn_permlane32_swap(__float_as_uint(v), __float_as_uint(v), false, false); return __uint_as_float(rr[0]) + __uint_as_float(rr[1]); }
__device__ __forceinline__ float xor32_max(float v) { auto rr = __builtin_amdgcn_permlane32_swap(__float_as_uint(v), __float_as_uint(v), false, false); return fmaxf(__uint_as_float(rr[0]), __uint_as_float(rr[1])); }
__device__ __forceinline__ float xor32_other(float v, int hi) { auto rr = __builtin_amdgcn_permlane32_swap(__float_as_uint(v), __float_as_uint(v), false, false); return __uint_as_float(hi ? rr[0] : rr[1]); }

__device__ __forceinline__ float row_rstd(const float* ssq, int row) {
    const f32x4 s = *(const f32x4*)(ssq + 4 * (size_t)row);
    return rsqrtf(((s[0] + s[1]) + (s[2] + s[3])) * (1.0f / 1024.0f) + EPS);
}
#define WG_BAR() do { asm volatile("s_waitcnt vmcnt(0) lgkmcnt(0)" ::: "memory"); __builtin_amdgcn_s_barrier(); asm volatile("" ::: "memory"); } while (0)

template <int MODE> struct EpiX {
    static constexpr bool PERM = false, AFTER_DRAIN = true;
    const float* xold; float* xnew; bf16* xb; float* ssq_out; const float* ssq_in; const bf16* pp;
    __device__ __forceinline__ void fused(pg8::f32x4 (&acc)[2][2][4][2], const pg8::Unit& u, int wr, int wc, int fr, int fq, PG8_LAS unsigned char* lds, int wid, int lane) const {
        LAS float* P = (LAS float*)lds;
        const int col0 = u.pn * 256 + wc * 32 + 4 * fq;
#pragma unroll
        for (int ai = 0; ai < 2; ++ai)
#pragma unroll
            for (int m = 0; m < 4; ++m) {
                const int r = ai * 128 + wr * 64 + m * 16 + fr, grow = u.pm * 256 + r; const size_t off = (size_t)grow * D + col0;
                float rs = 0.f; if (MODE == 1) rs = row_rstd(ssq_in, grow);
                float sq = 0.f;
#pragma unroll
                for (int bj = 0; bj < 2; ++bj)
#pragma unroll
                    for (int n = 0; n < 2; ++n) {
                        const size_t c = off + bj * 128 + n * 16;
                        f32x4 v = acc[ai][bj][m][n];
                        if (MODE == 1) { const u32x2 w = *(const u32x2*)(pp + c);
                            v[0] = sigmoidf_(rs * v[0]) * bf_lo(w.x); v[1] = sigmoidf_(rs * v[1]) * bf_hi(w.x); v[2] = sigmoidf_(rs * v[2]) * bf_lo(w.y); v[3] = sigmoidf_(rs * v[3]) * bf_hi(w.y); }
                        const f32x4 xo = *(const f32x4*)(xold + c); const f32x4 xn = xo + v;
                        *(f32x4*)(xnew + c) = xn;
                        u32x2 o; o.x = cvt_pk_bf16(xn[0], xn[1]); o.y = cvt_pk_bf16(xn[2], xn[3]); *(u32x2*)(xb + c) = o;
                        sq += (xn[0] * xn[0] + xn[1] * xn[1]) + (xn[2] * xn[2] + xn[3] * xn[3]);
                    }
                sq += swz_xor<16>(sq); sq = xor32_sum(sq);
                if (fq == 0) P[r * 4 + wc] = sq;
            }
        WG_BAR();
        const int tid = wid * 64 + lane;
        if (tid < 256) { const float s = (P[tid * 4 + 0] + P[tid * 4 + 1]) + (P[tid * 4 + 2] + P[tid * 4 + 3]); ssq_out[(size_t)(u.pm * 256 + tid) * 4 + u.pn] = s; }
        WG_BAR();
    }
};

struct EpiPP {
    static constexpr bool PERM = true, AFTER_DRAIN = false;
    bf16* O;
    __device__ __forceinline__ void operator()(const pg8::f32x4 (&acc)[2][2][4][2], const pg8::Unit& u, int wr, int wc, int fr, int fq) const {
        const int row0 = u.pm * 256 + wr * 64 + fr, col0 = u.pn * 256 + wc * 32 + 8 * fq;
#pragma unroll
        for (int ai = 0; ai < 2; ++ai)
#pragma unroll
            for (int m = 0; m < 4; ++m) { bf16* rowp = O + (size_t)(row0 + ai * 128 + m * 16) * D + col0;
#pragma unroll
                for (int bj = 0; bj < 2; ++bj) { const f32x4 v0 = acc[ai][bj][m][0], v1 = acc[ai][bj][m][1];
                    u32x4 w; w.x = cvt_pk_bf16(v0[0], v0[1]); w.y = cvt_pk_bf16(v0[2], v0[3]); w.z = cvt_pk_bf16(v1[0], v1[1]); w.w = cvt_pk_bf16(v1[2], v1[3]);
                    *(u32x4*)(rowp + bj * 128) = w; } }
    }
};

struct EpiKVQ {
    static constexpr bool PERM = true, AFTER_DRAIN = false;
    const float* ssq_in; const float* rope;
    bf16* kvb; bf16* qb; float* gates; int n_kv;
    __device__ __forceinline__ void operator()(const pg8::f32x4 (&acc)[2][2][4][2], const pg8::Unit& u, int wr, int wc, int fr, int fq) const {
        const int pn = u.pn; const int kind = pn < n_kv ? 0 : (pn < n_kv + 4 ? 1 : 2);
        const bool roped = (kind == 1) || (kind == 0 && (pn == 2 || pn == 4));
        const bool rope_wave = roped && ((wc & 1) == 0);
        const float sgn = (fq == 0) ? -1.f : 1.f;
#pragma unroll
        for (int ai = 0; ai < 2; ++ai)
#pragma unroll
            for (int m = 0; m < 4; ++m) {
                const int grow = u.pm * 256 + ai * 128 + wr * 64 + m * 16 + fr;
                const float rs = row_rstd(ssq_in, grow);
                f32x4 cs0 = {1.f, 1.f, 1.f, 1.f}, cs1 = cs0, sn0 = {0.f, 0.f, 0.f, 0.f}, sn1 = sn0;
                if (rope_wave && fq < 2) { const f32x4* rp = (const f32x4*)(rope + (size_t)grow * 16); cs0 = rp[0]; cs1 = rp[1]; sn0 = rp[2]; sn1 = rp[3]; }
#pragma unroll
                for (int bj = 0; bj < 2; ++bj) {
                    f32x4 v0 = acc[ai][bj][m][0] * rs, v1 = acc[ai][bj][m][1] * rs;
                    if (rope_wave) {
                        f32x4 p0, p1;
#pragma unroll
                        for (int e = 0; e < 4; ++e) { p0[e] = swz_xor<16>(v0[e]); p1[e] = swz_xor<16>(v1[e]); }
                        if (fq < 2) { v0 = v0 * cs0 + (p0 * sn0) * sgn; v1 = v1 * cs1 + (p1 * sn1) * sgn; }
                    }
                    const int cl = bj * 128 + wc * 32 + 8 * fq;
                    if (kind == 2) {
                        if (cl < 48) { float* g = gates + (size_t)grow * 48 + cl;
                            f32x4 a, b;
#pragma unroll
                            for (int e = 0; e < 4; ++e) { a[e] = sigmoidf_(v0[e]); b[e] = sigmoidf_(v1[e]); }
                            *(f32x4*)g = a; *(f32x4*)(g + 4) = b; }
                    } else {
                        if (kind == 1) { v0 = v0 * QSCALE; v1 = v1 * QSCALE; }
                        u32x4 w; w.x = cvt_pk_bf16(v0[0], v0[1]); w.y = cvt_pk_bf16(v0[2], v0[3]); w.z = cvt_pk_bf16(v1[0], v1[1]); w.w = cvt_pk_bf16(v1[2], v1[3]);
                        bf16* dst = (kind == 0) ? kvb + (size_t)grow * NKV + pn * 256 + cl : qb + (size_t)grow * D + (pn - n_kv) * 256 + cl;
                        *(u32x4*)dst = w;
                    }
                }
            }
    }
};

struct EpiCMP {
    static constexpr bool PERM = true, AFTER_DRAIN = false;
    const float* bias1;
    bf16* hid;
    __device__ __forceinline__ void operator()(const pg8::f32x4 (&acc)[2][2][4][2], const pg8::Unit& u, int wr, int wc, int fr, int fq) const {
        const int which = u.pn; const int cl = wc * 32 + 8 * fq;
        const f32x4 b0 = *(const f32x4*)(bias1 + which * 128 + cl), b1 = *(const f32x4*)(bias1 + which * 128 + cl + 4);
#pragma unroll
        for (int ai = 0; ai < 2; ++ai)
#pragma unroll
            for (int m = 0; m < 4; ++m) {
                const int row = u.pm * 256 + ai * 128 + wr * 64 + m * 16 + fr;
                f32x4 v0 = acc[ai][0][m][0] + b0, v1 = acc[ai][0][m][1] + b1;
#pragma unroll
                for (int e = 0; e < 4; ++e) {
                    { const float x = v0[e]; const float y = 0.7978845608028654f * (x + 0.044715f * x * x * x); v0[e] = x / (1.0f + __expf(-2.0f * y)); }
                    { const float x = v1[e]; const float y = 0.7978845608028654f * (x + 0.044715f * x * x * x); v1[e] = x / (1.0f + __expf(-2.0f * y)); }
                }
                u32x4 w; w.x = cvt_pk_bf16(v0[0], v0[1]); w.y = cvt_pk_bf16(v0[2], v0[3]); w.z = cvt_pk_bf16(v1[0], v1[1]); w.w = cvt_pk_bf16(v1[2], v1[3]);
                *(u32x4*)(hid + ((size_t)which * 4096 + row) * 128 + cl) = w;
            }
    }
};

struct EpiUP {
    static constexpr bool PERM = true, AFTER_DRAIN = true;
    const float* ssq_in; const float* convw; const float* convb;
    bf16* h;
    __device__ __forceinline__ void fused(pg8::f32x4 (&acc)[2][2][4][2], const pg8::Unit& u, int wr, int wc, int fr, int fq, PG8_LAS unsigned char* lds, int wid, int lane) const {
        LAS bf16* T = (LAS bf16*)lds;
        const int rbase = UPM * u.pm - 2;
#pragma unroll
        for (int ai = 0; ai < 2; ++ai)
#pragma unroll
            for (int m = 0; m < 4; ++m) {
                const int rl = ai * 128 + wr * 64 + m * 16 + fr; int grow = rbase + rl; grow = grow < 0 ? 0 : (grow >= M ? M - 1 : grow);
                const float rs = row_rstd(ssq_in, grow);
#pragma unroll
                for (int bj = 0; bj < 2; ++bj) { const f32x4 v0 = acc[ai][bj][m][0] * rs, v1 = acc[ai][bj][m][1] * rs;
                    u32x4 w; w.x = cvt_pk_bf16(v0[0], v0[1]); w.y = cvt_pk_bf16(v0[2], v0[3]); w.z = cvt_pk_bf16(v1[0], v1[1]); w.w = cvt_pk_bf16(v1[2], v1[3]);
                    *(LAS u32x4*)(T + rl * TPITCH + bj * 128 + wc * 32 + 8 * fq) = w; }
            }
        WG_BAR();
        const int tid = wid * 64 + lane, c8 = tid & 15, rsub = tid >> 4;
        const int hc = u.pn * 128 + c8 * 8;
        float wa[3][8], wg[3][8], ba[8], bg[8];
#pragma unroll
        for (int t = 0; t < 3; ++t) {
            const f32x4 a0 = *(const f32x4*)(convw + t * FF2 + hc), a1 = *(const f32x4*)(convw + t * FF2 + hc + 4);
            const f32x4 g0 = *(const f32x4*)(convw + t * FF2 + FF + hc), g1 = *(const f32x4*)(convw + t * FF2 + FF + hc + 4);
#pragma unroll
            for (int e = 0; e < 4; ++e) { wa[t][e] = a0[e]; wa[t][4 + e] = a1[e]; wg[t][e] = g0[e]; wg[t][4 + e] = g1[e]; }
        }
        { const f32x4 a0 = *(const f32x4*)(convb + hc), a1 = *(const f32x4*)(convb + hc + 4), g0 = *(const f32x4*)(convb + FF + hc), g1 = *(const f32x4*)(convb + FF + hc + 4);
#pragma unroll
          for (int e = 0; e < 4; ++e) { ba[e] = a0[e]; ba[4 + e] = a1[e]; bg[e] = g0[e]; bg[4 + e] = g1[e]; } }
        for (int p = 0; p < 8; ++p) {
            const int rl = p * 32 + rsub; const int grow = rbase + rl;
            if (rl >= 2 && grow < M) {
                const int t = grow & (SEQ - 1);
                const u32x4 z = {0u, 0u, 0u, 0u};
                const u32x4 a2 = *(const LAS u32x4*)(T + rl * TPITCH + c8 * 8), g2 = *(const LAS u32x4*)(T + rl * TPITCH + 128 + c8 * 8);
                u32x4 a1 = *(const LAS u32x4*)(T + (rl - 1) * TPITCH + c8 * 8), g1 = *(const LAS u32x4*)(T + (rl - 1) * TPITCH + 128 + c8 * 8);
                u32x4 a0 = *(const LAS u32x4*)(T + (rl - 2) * TPITCH + c8 * 8), g0 = *(const LAS u32x4*)(T + (rl - 2) * TPITCH + 128 + c8 * 8);
                if (t < 1) { a1 = z; g1 = z; }
                if (t < 2) { a0 = z; g0 = z; }
                float o[8];
#pragma unroll
                for (int e = 0; e < 4; ++e) {
                    const unsigned A0 = a0[e], A1 = a1[e], A2 = a2[e], G0 = g0[e], G1 = g1[e], G2 = g2[e];
                    const float al = ba[2 * e] + wa[0][2 * e] * bf_lo(A0) + wa[1][2 * e] * bf_lo(A1) + wa[2][2 * e] * bf_lo(A2);
                    const float ah = ba[2 * e + 1] + wa[0][2 * e + 1] * bf_hi(A0) + wa[1][2 * e + 1] * bf_hi(A1) + wa[2][2 * e + 1] * bf_hi(A2);
                    const float gl = bg[2 * e] + wg[0][2 * e] * bf_lo(G0) + wg[1][2 * e] * bf_lo(G1) + wg[2][2 * e] * bf_lo(G2);
                    const float gh = bg[2 * e + 1] + wg[0][2 * e + 1] * bf_hi(G0) + wg[1][2 * e + 1] * bf_hi(G1) + wg[2][2 * e + 1] * bf_hi(G2);
                    o[2 * e] = gl * sigmoidf_(gl) * al; o[2 * e + 1] = gh * sigmoidf_(gh) * ah;
                }
                u32x4 w; w.x = cvt_pk_bf16(o[0], o[1]); w.y = cvt_pk_bf16(o[2], o[3]); w.z = cvt_pk_bf16(o[4], o[5]); w.w = cvt_pk_bf16(o[6], o[7]);
                *(u32x4*)(h + (size_t)grow * FF + hc) = w;
            }
        }
        WG_BAR();
    }
};

namespace att {
constexpr int LDS_K = 0, LDS_V = 16384, LDS_WS = 32768, LDS_IMP = 40960, LDS_TOT = 106496, LDS_SEL = 122880;
constexpr float NEGF = -1e30f;
typedef const LAS char* lcp;
typedef short v4i16_t __attribute__((ext_vector_type(4)));
__device__ __forceinline__ s16x4 vtr(lcp p) { return __builtin_bit_cast(s16x4, __builtin_amdgcn_ds_read_tr16_b64_v4i16((LAS v4i16_t*)p)); }
__device__ __forceinline__ int crow(int r, int hi) { return (r & 3) + 8 * (r >> 2) + 4 * hi; }

struct Ctx {
    LAS char* lds; int wid, lane, r32, hi, tl;
    bf16x8 qr[4];
    float m, l; f32x16 o[2];
    float inv_l, carry; int hp;
};

__device__ __forceinline__ void load_tile_regs(const bf16* kb, const bf16* vb, int pitch, int tile, int wid, int lane, u32x4& kr, u32x4& vr) {
    kr = *(const u32x4*)(kb + (size_t)(tile * 64 + lane) * pitch + wid * 8);
    vr = *(const u32x4*)(vb + (size_t)(tile * 64 + 16 * (wid & 3) + (lane >> 2)) * pitch + (wid >> 2) * 32 + (lane & 3) * 8);
}
__device__ __forceinline__ void store_tile_lds(LAS char* lds, int slot, int wid, int lane, const u32x4& kr, const u32x4& vr) {
    *(LAS u32x4*)(lds + LDS_K + slot * 8192 + wid * 1024 + lane * 16) = kr;
    *(LAS u32x4*)(lds + LDS_V + slot * 8192 + wid * 1024 + lane * 16) = vr;
}
__device__ __forceinline__ void qkt(f32x16& p0, f32x16& p1, lcp kslot, const bf16x8* qr, int r32, int hi) {
    lcp kb = kslot + hi * 1024 + r32 * 16;
    f32x16 z;
#pragma unroll
    for (int r = 0; r < 16; ++r) z[r] = 0.f;
    p0 = z; p1 = z;
#pragma unroll
    for (int d0 = 0; d0 < 4; ++d0) {
        const bf16x8 b0 = *(const LAS bf16x8*)(kb + d0 * 2048);
        const bf16x8 b1 = *(const LAS bf16x8*)(kb + d0 * 2048 + 512);
        p0 = __builtin_amdgcn_mfma_f32_32x32x16_bf16(b0, qr[d0], p0, 0, 0, 0);
        p1 = __builtin_amdgcn_mfma_f32_32x32x16_bf16(b1, qr[d0], p1, 0, 0, 0);
    }
}
__device__ __forceinline__ bf16x8 pack8(const f32x16& p, int b) {
    u32x4 w; w.x = cvt_pk_bf16(p[b], p[b + 1]); w.y = cvt_pk_bf16(p[b + 2], p[b + 3]); w.z = cvt_pk_bf16(p[b + 4], p[b + 5]); w.w = cvt_pk_bf16(p[b + 6], p[b + 7]);
    return __builtin_bit_cast(bf16x8, w);
}
__device__ __forceinline__ void pv(f32x16* o, lcp vp, const f32x16& p0, const f32x16& p1) {
    const bf16x8 pa0 = pack8(p0, 0), pa1 = pack8(p0, 8), pa2 = pack8(p1, 0), pa3 = pack8(p1, 8);
#pragma unroll
    for (int d0 = 0; d0 < 2; ++d0) {
#pragma unroll
        for (int ks = 0; ks < 4; ++ks) {
            const s16x4 lo = vtr(vp + d0 * 4096 + ks * 1024), hh = vtr(vp + d0 * 4096 + ks * 1024 + 512);
            const bf16x8 vf = {lo[0], lo[1], lo[2], lo[3], hh[0], hh[1], hh[2], hh[3]};
            const bf16x8 pa = ks == 0 ? pa0 : (ks == 1 ? pa1 : (ks == 2 ? pa2 : pa3));
            o[d0] = __builtin_amdgcn_mfma_f32_32x32x16_bf16(pa, vf, o[d0], 0, 0, 0);
        }
    }
}
template <bool ACCUM> __device__ __forceinline__ void scale_rows(Ctx& c, f32x16* dst, const f32x16* src, float f) {
    LAS float* wsf = (LAS float*)(c.lds + LDS_WS) + c.wid * 64;
    if (c.hi == 0) wsf[c.r32] = f;
    asm volatile("s_waitcnt lgkmcnt(0)" ::: "memory");
#pragma unroll
    for (int r = 0; r < 16; ++r) { const float fr_ = wsf[crow(r, c.hi)];
        if (ACCUM) { dst[0][r] += src[0][r] * fr_; dst[1][r] += src[1][r] * fr_; } else { dst[0][r] = src[0][r] * fr_; dst[1][r] = src[1][r] * fr_; } }
    asm volatile("s_waitcnt lgkmcnt(0)" ::: "memory");
}

template <int EM> __device__ __forceinline__ void emit(Ctx& c, float f, bf16* ob) {
    LAS float* wsf = (LAS float*)(c.lds + LDS_WS) + c.wid * 64;
    LAS float* outb = (LAS float*)(c.lds + LDS_IMP) + c.wid * 2048 + c.lane;
    if (c.hi == 0) wsf[c.r32] = f;
    asm volatile("s_waitcnt lgkmcnt(0)" ::: "memory");
#pragma unroll
    for (int r = 0; r < 16; ++r) { const float fr_ = wsf[crow(r, c.hi)];
#pragma unroll
        for (int d0 = 0; d0 < 2; ++d0) { float v = c.o[d0][r] * fr_; const int idx = d0 * 16 + r;
            if (EM == 0) outb[idx * 64] = v;
            else if (EM == 1) outb[idx * 64] += v;
            else { v += outb[idx * 64]; ob[(size_t)crow(r, c.hi) * D + 32 * d0] = (bf16)(cvt_pk_bf16(v, 0.f) & 0xffffu); } } }
    asm volatile("s_waitcnt lgkmcnt(0)" ::: "memory");
}

template <int MODE> __device__ __forceinline__ void tile_step(Ctx& c, int slot, int klo, int khi, int ct) {
    f32x16 p0, p1;
    qkt(p0, p1, (lcp)(c.lds + LDS_K + slot * 8192), c.qr, c.r32, c.hi);
    const int lo_ = klo - 4 * c.hi, hi_ = khi - 4 * c.hi;
    float rm = NEGF;
#pragma unroll
    for (int r = 0; r < 16; ++r) { const int kk = (r & 3) + 8 * (r >> 2);
        const bool v0 = (kk >= lo_) && (kk <= hi_), v1 = (kk + 32 >= lo_) && (kk + 32 <= hi_);
        p0[r] = v0 ? p0[r] : NEGF; p1[r] = v1 ? p1[r] : NEGF;
        rm = fmaxf(rm, fmaxf(p0[r], p1[r])); }
    rm = xor32_max(rm);
    if (MODE == 1) {
        const float mf = c.m, il = c.inv_l;
#pragma unroll
        for (int r = 0; r < 16; ++r) { p0[r] = (p0[r] > 0.5f * NEGF) ? __builtin_amdgcn_exp2f(p0[r] - mf) * il : 0.f; p1[r] = (p1[r] > 0.5f * NEGF) ? __builtin_amdgcn_exp2f(p1[r] - mf) * il : 0.f; }
        LAS float* imp = (LAS float*)(c.lds + LDS_IMP) + (c.hp * 64 + c.tl) * 64 + 16 * ct + c.hi;
#pragma unroll
        for (int h2 = 0; h2 < 2; ++h2) {
            const f32x16& p = h2 ? p1 : p0;
            float Y[4];
#pragma unroll
            for (int k = 0; k < 4; ++k) Y[k] = xor32_other(p[4 * k + 3], c.hi);
#pragma unroll
            for (int k = 0; k < 4; ++k) {
                const float g4 = (p[4 * k] + p[4 * k + 1]) + (p[4 * k + 2] + p[4 * k + 3]);
                const float prev = c.hi ? Y[k] : (k == 0 ? c.carry : Y[k - 1]);
                imp[8 * h2 + 2 * k] = g4 + prev;
            }
            c.carry = Y[3];
        }
        pv(c.o, (lcp)(c.lds + LDS_V + slot * 8192) + ((c.lane >> 4) & 1) * 32 + (c.lane & 3) * 8 + (4 * c.hi + ((c.lane & 15) >> 2)) * 64, p0, p1);
    } else {
        const float mn = fmaxf(c.m, rm);
        const float alpha = __builtin_amdgcn_exp2f(c.m - mn);
        float s = 0.f;
#pragma unroll
        for (int r = 0; r < 16; ++r) { p0[r] = (p0[r] > 0.5f * NEGF) ? __builtin_amdgcn_exp2f(p0[r] - mn) : 0.f; p1[r] = (p1[r] > 0.5f * NEGF) ? __builtin_amdgcn_exp2f(p1[r] - mn) : 0.f; s += p0[r] + p1[r]; }
        c.l = c.l * alpha + s; c.m = mn;
        if (MODE >= 2) {
            if (__any(alpha != 1.0f)) scale_rows<false>(c, c.o, c.o, alpha);
            pv(c.o, (lcp)(c.lds + LDS_V + slot * 8192) + ((c.lane >> 4) & 1) * 32 + (c.lane & 3) * 8 + (4 * c.hi + ((c.lane & 15) >> 2)) * 64, p0, p1);
        }
    }
}

struct MaskP { int cmaxq; unsigned sel_lo, sel_hi; int cur; };
template <int MODE> __device__ __forceinline__ void tile_mask(const Ctx& c, const MaskP& mp, int tile, int& klo, int& khi) {
    if (MODE <= 1) { klo = 0; khi = mp.cmaxq - 64 * tile; }
    else if (MODE == 2) { const unsigned bit = tile < 32 ? (mp.sel_lo >> tile) & 1u : (mp.sel_hi >> (tile - 32)) & 1u;
        klo = bit ? 0 : 64; khi = (tile == mp.cur) ? c.tl : 63; }
    else { if (tile == mp.cur) { klo = 0; khi = c.tl; } else if (tile == mp.cur - 8) { klo = c.tl + 1; khi = 63; } else { klo = 0; khi = 63; } }
}
template <int MODE> __device__ __forceinline__ void run_branch(Ctx& c, const MaskP& mp, const bf16* kb, const bf16* vb, int pitch, int tile0, int ntiles) {
    u32x4 kr, vr;
    load_tile_regs(kb, vb, pitch, tile0, c.wid, c.lane, kr, vr);
    store_tile_lds(c.lds, 0, c.wid, c.lane, kr, vr);
    __syncthreads();
    for (int i = 0; i < ntiles; ++i) {
        const bool more = (i + 1 < ntiles);
        if (more) load_tile_regs(kb, vb, pitch, tile0 + i + 1, c.wid, c.lane, kr, vr);
        int klo, khi; tile_mask<MODE>(c, mp, tile0 + i, klo, khi);
        tile_step<MODE>(c, i & 1, klo, khi, tile0 + i);
        if (more) store_tile_lds(c.lds, (i + 1) & 1, c.wid, c.lane, kr, vr);
        __syncthreads();
    }
}

struct Tensors { const bf16* qb; const bf16* kvb; const bf16* kc; const bf16* vc; const float* gates; bf16* ob; };

__device__ __forceinline__ void unit(const Tensors& T, int b, int g, int qb, LAS char* lds, const int tid) {
    Ctx c; c.lds = lds; c.lane = tid & 63; c.wid = __builtin_amdgcn_readfirstlane(tid >> 6); c.r32 = c.lane & 31; c.hi = c.lane >> 5;
    c.hp = c.wid >> 1; const int qh = c.wid & 1; c.tl = 32 * qh + c.r32;
    const int head = 4 * g + c.hp, s = qb * 64, t = s + c.tl; const size_t rowg = (size_t)b * SEQ + t;
#pragma unroll
    for (int d0 = 0; d0 < 4; ++d0) c.qr[d0] = *(const bf16x8*)(T.qb + rowg * D + head * 64 + d0 * 16 + c.hi * 8);
    const float g0 = T.gates[rowg * 48 + head * 3 + 0], g1 = T.gates[rowg * 48 + head * 3 + 1], g2 = T.gates[rowg * 48 + head * 3 + 2];
    MaskP mp; mp.cur = qb; mp.cmaxq = (t >= 31) ? ((t - 31) >> 4) : -1; mp.sel_lo = 0u; mp.sel_hi = 0u;
    const int nct = ((4 * qb + 2) >> 6) + 1;
    const int bg = b * 4 + g;
    const bf16* kcb = T.kc + (size_t)bg * 256 * 64; const bf16* vcb = T.vc + (size_t)bg * 256 * 64;
    const bf16* kvrow = T.kvb + (size_t)b * SEQ * NKV + g * 64;
#pragma unroll
    for (int r = 0; r < 16; ++r) { c.o[0][r] = 0.f; c.o[1][r] = 0.f; }
    c.m = NEGF; c.l = 0.f; c.inv_l = 0.f; c.carry = 0.f;
    run_branch<0>(c, mp, kcb, vcb, 64, 0, nct);
    { const float lt = xor32_sum(c.l); c.inv_l = lt > 0.f ? 1.0f / lt : 0.f; }
    run_branch<1>(c, mp, kcb, vcb, 64, 0, nct);
    {
        LAS float* imp = (LAS float*)(lds + LDS_IMP); LAS float* tot = (LAS float*)(lds + LDS_TOT); LAS unsigned* selw = (LAS unsigned*)(lds + LDS_SEL);
        const int cur = qb;
        for (int idx = tid; idx < 4096; idx += 512) { const int n = idx & 63;
            float v = 0.f; if (n <= cur) v = ((imp[idx] + imp[4096 + idx]) + imp[8192 + idx]) + imp[12288 + idx];
            tot[idx] = v; }
        __syncthreads();
        const int q = tid >> 3, sub = tid & 7; const int nf = cur >= 2 ? 3 : cur + 1; const int Kn = 16 - nf;
        unsigned bits = 0u;
        for (int i = 0; i < 8; ++i) { const int n = sub * 8 + i; bool sb;
            if (n > cur) sb = false; else if (n == 0 || n >= cur - 1) sb = true;
            else { const float v = tot[q * 64 + n]; int rank = 0;
                for (int n2 = 1; n2 <= cur - 2; ++n2) { const float v2 = tot[q * 64 + n2]; rank += ((v2 > v) || (v2 == v && n2 < n)) ? 1 : 0; }
                sb = rank < Kn; }
            bits |= (sb ? 1u : 0u) << i; }
        unsigned lo32 = sub < 4 ? bits << (8 * sub) : 0u, hi32 = sub >= 4 ? bits << (8 * (sub - 4)) : 0u;
        lo32 |= swz_xor_u<1>(lo32); hi32 |= swz_xor_u<1>(hi32); lo32 |= swz_xor_u<2>(lo32); hi32 |= swz_xor_u<2>(hi32); lo32 |= swz_xor_u<4>(lo32); hi32 |= swz_xor_u<4>(hi32);
        if (sub == 0) { selw[q * 2] = lo32; selw[q * 2 + 1] = hi32; }
        __syncthreads();
        mp.sel_lo = selw[c.tl * 2]; mp.sel_hi = selw[c.tl * 2 + 1];
    }
    bf16* ob = T.ob + ((size_t)b * SEQ + s + 32 * qh) * D + head * 64 + c.r32;
    emit<0>(c, g0, ob);
#pragma unroll
    for (int r = 0; r < 16; ++r) { c.o[0][r] = 0.f; c.o[1][r] = 0.f; }
    c.m = NEGF; c.l = 0.f;
    run_branch<2>(c, mp, kvrow + 512, kvrow + 768, NKV, 0, qb + 1);
    { const float lt = xor32_sum(c.l); emit<1>(c, lt > 0.f ? g1 / lt : 0.f, ob); }
#pragma unroll
    for (int r = 0; r < 16; ++r) { c.o[0][r] = 0.f; c.o[1][r] = 0.f; }
    c.m = NEGF; c.l = 0.f;
    { const int w0 = qb >= 8 ? qb - 8 : 0; run_branch<3>(c, mp, kvrow + 1024, kvrow + 1280, NKV, w0, qb - w0 + 1); }
    { const float lt = xor32_sum(c.l); emit<2>(c, lt > 0.f ? g2 / lt : 0.f, ob); }
    __syncthreads();
}
}

constexpr size_t MiB = 1u << 20, KiB = 1u << 10;
constexpr size_t WS_CTL = 0, CTL_ZERO_BYTES = 1 * MiB;
constexpr size_t WS_SSQ0 = 1 * MiB, WS_SSQ1 = 1 * MiB + 512 * KiB;
constexpr size_t WS_ROPE = 2 * MiB;
constexpr size_t WS_ROPEC = 3 * MiB;
constexpr size_t WS_CB1 = 3 * MiB + 128 * KiB;
constexpr size_t WS_GATES = 4 * MiB;
constexpr size_t WS_KC = 7 * MiB, WS_VC = 7 * MiB + 512 * KiB;
constexpr size_t WS_HID = 8 * MiB;
constexpr size_t WS_WUP = 16 * MiB;
constexpr size_t WS_WDN = 60 * MiB;
constexpr size_t WS_WG = 82 * MiB;
constexpr size_t WS_WPP = 90 * MiB;
constexpr size_t WS_WPOOL = 92 * MiB;
constexpr size_t WS_WKVQ2 = 93 * MiB;
constexpr size_t WS_WQ3 = 99 * MiB;
constexpr size_t WS_WOUT = 102 * MiB;
constexpr size_t WS_WC1 = 106 * MiB;
constexpr size_t WS_PB = 108 * MiB;
constexpr size_t WS_PP = 140 * MiB;
constexpr size_t WS_XB = 173 * MiB;
constexpr size_t WS_KVB = 206 * MiB;
constexpr size_t WS_H = 255 * MiB;
constexpr size_t WS_QO = WS_H;
constexpr size_t WS_UPOOL = WS_H;
constexpr size_t WS_XBG = WS_H + 32 * MiB;
constexpr size_t WS_END = 343 * MiB;
constexpr int CW_BAR = 4096;

constexpr int RING_BYTES = 131072;
constexpr int LDSCTL_OFF = 139264, MISC_OFF = LDSCTL_OFF + 320;
constexpr int LDS_BYTES = LDSCTL_OFF + 1024;
constexpr int NWAVES = 8;

typedef GAS unsigned gu32;
#define RLX_AGENT __ATOMIC_RELAXED, __HIP_MEMORY_SCOPE_AGENT
#define LDS_WAIT() asm volatile("s_waitcnt lgkmcnt(0)" ::: "memory")
__device__ __forceinline__ unsigned f2bf(float f) { unsigned u = __builtin_bit_cast(unsigned, f); return (u + 0x7fffu + ((u >> 16) & 1u)) >> 16; }
__device__ __forceinline__ unsigned pk2(float lo, float hi) { return f2bf(lo) | (f2bf(hi) << 16); }
__device__ __forceinline__ float wave_sum(float v) {
    v += swz_xor<1>(v); v += swz_xor<2>(v); v += swz_xor<4>(v); v += swz_xor<8>(v); v += swz_xor<16>(v);
    return xor32_sum(v);
}

#define XB_TMO      128
#define XB_XCNT(j)  (256  + 64 * (j))
#define XB_XSUB(j)  (1280 + 64 * (j))
#define XB_XGEN(j)  (2304 + 64 * (j))
#define XB_TOP      3328
#define XB_TOPGEN   3392
#define XCD_BAR_WORDS 3456
#define XB_SPIN_CAP (1u << 18)

__device__ __forceinline__ unsigned xb_ld(unsigned* p)              { return __hip_atomic_load(p, __ATOMIC_RELAXED, __HIP_MEMORY_SCOPE_AGENT); }
__device__ __forceinline__ unsigned xb_add(unsigned* p, unsigned v) { return __hip_atomic_fetch_add(p, v, __ATOMIC_RELAXED, __HIP_MEMORY_SCOPE_AGENT); }
__device__ __forceinline__ unsigned xb_xcc_id() { return (unsigned)__builtin_amdgcn_s_getreg((3 << 11) | 20) & 0xFu; }
#define XB_SPIN(cond, bar) do { unsigned _sp = 0; while (cond) { __builtin_amdgcn_s_sleep(1); \
    if ((++_sp & 255u) == 0u) { if (xb_ld(&(bar)[XB_TMO])) break; if (_sp > XB_SPIN_CAP) { atomicAdd(&(bar)[XB_TMO], 1u); break; } } } } while (0)

struct XcdBarrier {
    unsigned* bar; unsigned x;
    volatile LAS unsigned* st;
};

__device__ __forceinline__ XcdBarrier xcd_barrier_post(unsigned* bar, volatile LAS unsigned* st) {
    XcdBarrier b; b.bar = bar; b.x = xb_xcc_id(); b.st = st;
    if (threadIdx.x == 0) (void)xb_add(&bar[XB_XCNT(b.x)], 1u);
    return b;
}
__device__ __forceinline__ void xcd_barrier_complete(unsigned* bar, unsigned x, unsigned& nloc, unsigned& nx) {
    const unsigned G = gridDim.x * gridDim.y * gridDim.z;
    unsigned sum, cnt, mine, sp = 0u;
    for (;;) {
        sum = 0u; cnt = 0u; mine = 0u;
#pragma unroll
        for (unsigned j = 0; j < 16; ++j) { const unsigned c = xb_ld(&bar[XB_XCNT(j)]); sum += c; cnt += (c > 0u) ? 1u : 0u; mine = (j == x) ? c : mine; }
        if (sum == G) break;
        __builtin_amdgcn_s_sleep(1);
        if ((++sp & 255u) == 0u) { if (xb_ld(&bar[XB_TMO])) break; if (sp > XB_SPIN_CAP) { atomicAdd(&bar[XB_TMO], 1u); break; } }
    }
    nloc = mine > 0u ? mine : 1u; nx = cnt > 0u ? cnt : 1u;
}

__device__ __forceinline__ void xcd_barrier(const XcdBarrier& b) {
    asm volatile("s_waitcnt vmcnt(0)" ::: "memory");
    __syncthreads();
    if (threadIdx.x == 0) {
        unsigned* bar = b.bar;
        __builtin_amdgcn_s_waitcnt(0);
        unsigned nloc = b.st[0], nx = b.st[1];
        if (nloc == 0u) { xcd_barrier_complete(bar, b.x, nloc, nx); b.st[0] = nloc; b.st[1] = nx; }
        const unsigned old = xb_add(&bar[XB_XSUB(b.x)], 1u);
        const unsigned gen = old / nloc;
        if (old + 1u == (gen + 1u) * nloc) {
            __builtin_amdgcn_fence(__ATOMIC_RELEASE, "agent");
            asm volatile("s_waitcnt vmcnt(0)" ::: "memory");
            const unsigned og = xb_add(&bar[XB_TOP], 1u);
            const unsigned tg = og / nx;
            if (og + 1u == (tg + 1u) * nx) xb_add(&bar[XB_TOPGEN], 1u);
            else XB_SPIN(xb_ld(&bar[XB_TOPGEN]) == tg, bar);
            __builtin_amdgcn_fence(__ATOMIC_ACQUIRE, "agent");
            xb_add(&bar[XB_XGEN(b.x)], 1u);
            asm volatile("s_waitcnt vmcnt(0)" ::: "memory");
        } else {
            XB_SPIN(xb_ld(&bar[XB_XGEN(b.x)]) == gen, bar);
            __builtin_amdgcn_fence(__ATOMIC_ACQUIRE, "agent");
            asm volatile("s_waitcnt vmcnt(0)" ::: "memory");
        }
    }
    __syncthreads();
}


struct Args { const void* in[25]; float* out; unsigned char* ws; int ph_lo, ph_hi; };

struct Frame {
    LAS unsigned char* lds;
    int tid, lane, wave, vcu, G;
    unsigned char* ws;
};

__device__ __forceinline__ void transpose_item(const float* W, int N, int k0, int n0, bf16* WT, int ldt, int dst_row0, const float* gk, const float* gn, LAS float* scr, int lane) {
    const int n = n0 + (lane & 31); const bool nv = n < N;
    const float sn = (gn && nv) ? gn[n] : 1.0f;
#pragma unroll 8
    for (int i = 0; i < 32; ++i) { const int kk = 2 * i + (lane >> 5);
        float v = nv ? W[(size_t)(k0 + kk) * N + n] : 0.f; if (gk) v *= gk[k0 + kk]; scr[kk * 33 + (lane & 31)] = v * sn; }
    LDS_WAIT(); asm volatile("" ::: "memory");
    const int c = lane & 7;
#pragma unroll
    for (int j = 0; j < 4; ++j) { const int nn = (lane >> 3) + 8 * j; const LAS float* s = scr + (8 * c) * 33 + nn;
        u32x4 o; o.x = pk2(s[0 * 33], s[1 * 33]); o.y = pk2(s[2 * 33], s[3 * 33]); o.z = pk2(s[4 * 33], s[5 * 33]); o.w = pk2(s[6 * 33], s[7 * 33]);
        *(u32x4*)(WT + (size_t)(dst_row0 + nn) * ldt + k0 + 8 * c) = o; }
    LDS_WAIT(); asm volatile("" ::: "memory");
}
__device__ __forceinline__ void sincos_f(float a, float& cs, float& sn) {
    const float q = rintf(a * 0.636619772f); float r = fmaf(-q, 1.5707963705062866f, a); r = fmaf(-q, -4.37113883e-8f, r);
    const float r2 = r * r;
    const float sp = r * (1.0f + r2 * (-1.666666667e-1f + r2 * (8.333333333e-3f + r2 * (-1.984126984e-4f + r2 * 2.755731922e-6f))));
    const float cp = 1.0f + r2 * (-0.5f + r2 * (4.166666667e-2f + r2 * (-1.388888889e-3f + r2 * 2.480158730e-5f)));
    const int qi = ((int)q) & 3;
    sn = (qi == 0) ? sp : (qi == 1) ? cp : (qi == 2) ? -sp : -cp;
    cs = (qi == 0) ? cp : (qi == 1) ? -sp : (qi == 2) ? -cp : sp;
}
__device__ __forceinline__ float inv_freq(int j) {
    return j == 0 ? 0x1.0p+0f : j == 1 ? 0x1.8d275ep-3f : j == 2 ? 0x1.341190p-5f : j == 3 ? 0x1.ddee9cp-8f : j == 4 ? 0x1.72ba44p-10f : j == 5 ? 0x1.1f91f0p-12f : j == 6 ? 0x1.be2188p-15f : 0x1.5a0f4ep-17f;
}

__device__ __forceinline__ void phase_prologue(Frame& F, const Args& a) {
    const float* x = (const float*)a.in[0]; const float* p = (const float*)a.in[1]; const int* pos = (const int*)a.in[2];
    const float* norm_mix = (const float*)a.in[3]; const float* pool_w = (const float*)a.in[4]; const float* pool_scale = (const float*)a.in[5];
    const float* norm_kv = (const float*)a.in[6]; const float* w_kv = (const float*)a.in[7];
    const float* cmp_pos_k = (const float*)a.in[8]; const float* cmp_pos_v = (const float*)a.in[11]; const float* cmp_w1_k = (const float*)a.in[9]; const float* cmp_w1_v = (const float*)a.in[12];
    const float* w_in = (const float*)a.in[14]; const float* w_out = (const float*)a.in[15];
    const float* norm_ffn = (const float*)a.in[16]; const float* ffn_up = (const float*)a.in[17]; const float* ffn_down = (const float*)a.in[20];
    const float* norm_ple = (const float*)a.in[21]; const float* ple_gate = (const float*)a.in[22]; const float* ple_proj = (const float*)a.in[23];
    unsigned char* ws = F.ws;
    LAS float* scr = (LAS float*)(F.lds + F.wave * 16384);
    const int gw = F.vcu * NWAVES + F.wave, NGW = F.G * NWAVES;
    const int gt = gw * 64 + F.lane, NGT = NGW * 64;
    constexpr int I_UP = 16 * 176, I_DN = 44 * 32, I_G = 16 * 32, I_PP = 4 * 32, I_POOL = 4 * 8, I_KV = 16 * 48, I_IN = 16 * 34, I_OUT = 16 * 32, I_C1 = 32 * 4;
    constexpr int T_UP = 4 * I_UP, T_DN = 4 * I_DN, T_G = 4 * I_G, T_PP = 4 * I_PP, T_POOL = 8 * I_POOL, T_KV = I_KV, T_IN = 2 * I_IN, T_OUT = 2 * I_OUT, T_C1 = 2 * I_C1;
    constexpr int NITEMS = T_UP + T_DN + T_G + T_PP + T_POOL + T_KV + T_IN + T_OUT + T_C1;
    for (int it = gw; it < NITEMS; it += NGW) {
        int r = it;
        if (r < T_UP) { const int l = r / I_UP, q = r % I_UP, kb = q / 176, nb = q % 176, n0 = 32 * nb;
            const int dst = (n0 < FF) ? (n0 / 128) * 256 + (n0 % 128) : ((n0 - FF) / 128) * 256 + 128 + ((n0 - FF) % 128);
            transpose_item(ffn_up + (size_t)l * D * FF2, FF2, 64 * kb, n0, (bf16*)(ws + WS_WUP) + (size_t)l * FF2 * D, D, dst, norm_ffn + l * D, nullptr, scr, F.lane); continue; } r -= T_UP;
        if (r < T_DN) { const int l = r / I_DN, q = r % I_DN, kb = q / 32, nb = q % 32;
            transpose_item(ffn_down + (size_t)l * FF * D, D, 64 * kb, 32 * nb, (bf16*)(ws + WS_WDN) + (size_t)l * D * FF, FF, 32 * nb, nullptr, nullptr, scr, F.lane); continue; } r -= T_DN;
        if (r < T_G) { const int l = r / I_G, q = r % I_G, kb = q / 32, nb = q % 32;
            transpose_item(ple_gate + (size_t)l * D * D, D, 64 * kb, 32 * nb, (bf16*)(ws + WS_WG) + (size_t)l * D * D, D, 32 * nb, norm_ple + l * D, nullptr, scr, F.lane); continue; } r -= T_G;
        if (r < T_PP) { const int l = r / I_PP, q = r % I_PP, kb = q / 32, nb = q % 32;
            transpose_item(ple_proj + (size_t)l * PLE * D, D, 64 * kb, 32 * nb, (bf16*)(ws + WS_WPP) + (size_t)l * D * PLE, PLE, 32 * nb, nullptr, nullptr, scr, F.lane); continue; } r -= T_PP;
        if (r < T_POOL) { const int lg = r / I_POOL, q = r % I_POOL, kb = q / 8, nb = q % 8, l = lg >> 2, gi = lg & 3;
            transpose_item(pool_w + (size_t)lg * 256 * 256, 256, 64 * kb, 32 * nb, (bf16*)(ws + WS_WPOOL) + (size_t)l * D * 256, 256, gi * 256 + 32 * nb, nullptr, pool_scale + l * D + gi * 256, scr, F.lane); continue; } r -= T_POOL;
        if (r < T_KV) { const int kb = r / 48, nb = r % 48;
            transpose_item(w_kv, NKV, 64 * kb, 32 * nb, (bf16*)(ws + WS_WKVQ2), D, 32 * nb, norm_kv, nullptr, scr, F.lane); continue; } r -= T_KV;
        if (r < T_IN) { const int j = r / I_IN, q = r % I_IN, kb = q / 34, nb = q % 34;
            bf16* dstp = j == 0 ? (bf16*)(ws + WS_WKVQ2) + (size_t)NKV * D : (bf16*)(ws + WS_WQ3);
            transpose_item(w_in + (size_t)j * D * NQC, NQC, 64 * kb, 32 * nb, dstp, D, 32 * nb, norm_mix + (2 + j) * D, nullptr, scr, F.lane); continue; } r -= T_IN;
        if (r < T_OUT) { const int j = r / I_OUT, q = r % I_OUT, kb = q / 32, nb = q % 32;
            transpose_item(w_out + (size_t)j * D * D, D, 64 * kb, 32 * nb, (bf16*)(ws + WS_WOUT) + (size_t)j * D * D, D, 32 * nb, nullptr, nullptr, scr, F.lane); continue; } r -= T_OUT;
        { const int wh = r / I_C1, q = r % I_C1, kb = q / 4, nb = q % 4;
            transpose_item(wh ? cmp_w1_v : cmp_w1_k, 128, 64 * kb, 32 * nb, (bf16*)(ws + WS_WC1) + (size_t)wh * 256 * 2048, 2048, 32 * nb, nullptr, nullptr, scr, F.lane); }
    }
    {
        constexpr int Z1 = 192 * D / 8, Z3 = 128 * 2048 / 8;
        for (int i = gt; i < 2 * Z1 + 2 * Z3; i += NGT) {
            u32x4* dst;
            if (i < Z1) dst = (u32x4*)((bf16*)(ws + WS_WKVQ2) + (size_t)2624 * D) + i;
            else if (i < 2 * Z1) dst = (u32x4*)((bf16*)(ws + WS_WQ3) + (size_t)1088 * D) + (i - Z1);
            else if (i < 2 * Z1 + Z3) dst = (u32x4*)((bf16*)(ws + WS_WC1) + (size_t)128 * 2048) + (i - 2 * Z1);
            else dst = (u32x4*)((bf16*)(ws + WS_WC1) + (size_t)256 * 2048 + (size_t)128 * 2048) + (i - 2 * Z1 - Z3);
            unsigned zz = 0u; asm volatile("" : "+v"(zz)); const u32x4 z = {zz, zz, zz, zz};
            *dst = z;
        }
    }
    { const f32x4* src = (const f32x4*)p; u32x4* dst = (u32x4*)(ws + WS_PB); const int n8 = DEPTH * M * PLE / 8;
      for (int i = gt; i < n8; i += NGT) { const f32x4 a0 = src[2 * i], a1 = src[2 * i + 1]; u32x4 o; o.x = pk2(a0[0], a0[1]); o.y = pk2(a0[2], a0[3]); o.z = pk2(a1[0], a1[1]); o.w = pk2(a1[2], a1[3]); dst[i] = o; } }
    { float* rope = (float*)(ws + WS_ROPE);
      for (int i = gt; i < M * 8; i += NGT) { const int row = i >> 3, j = i & 7; const float ang = (float)pos[row] * inv_freq(j); float cs, sn; sincos_f(ang, cs, sn); rope[row * 16 + j] = cs; rope[row * 16 + 8 + j] = sn; }
      float* ropec = (float*)(ws + WS_ROPEC);
      for (int i = gt; i < NBATCH * 256 * 8; i += NGT) { const int j = i & 7, c = (i >> 3) & 255, b = i >> 11; float cs = 1.f, sn = 0.f;
          if (c < 255) { const float ang = (float)pos[b * SEQ + 16 * c + 31] * inv_freq(j); sincos_f(ang, cs, sn); }
          ropec[(b * 256 + c) * 16 + j] = cs; ropec[(b * 256 + c) * 16 + 8 + j] = sn; } }
    { float* cb1 = (float*)(ws + WS_CB1);
      for (int o = gw; o < 256; o += NGW) { const int wh = o >> 7, j = o & 127; float s = 0.f;
          const float* cp_ = wh ? cmp_pos_v : cmp_pos_k; const float* cw_ = wh ? cmp_w1_v : cmp_w1_k;
          for (int k = F.lane; k < 2048; k += 64) s += cp_[k] * cw_[(size_t)k * 128 + j];
          s = wave_sum(s); if (F.lane == 0) cb1[o] = s; } }
    { float* ssq = (float*)(ws + WS_SSQ0);
      for (int m = gw; m < M; m += NGW) { const f32x4* xr = (const f32x4*)(x + (size_t)m * D) + F.lane; float s = 0.f;
#pragma unroll
          for (int j = 0; j < 4; ++j) { const f32x4 v = xr[64 * j]; s += (v[0] * v[0] + v[1] * v[1]) + (v[2] * v[2] + v[3] * v[3]); }
          s = wave_sum(s); if (F.lane == 0) { f32x4 o = {s, 0.f, 0.f, 0.f}; *(f32x4*)(ssq + (size_t)m * 4) = o; } } }
}

__device__ __forceinline__ void phase_poolprep(Frame& F, const float* xsrc, const float* ssq, const float* gmix, bf16* upool) {
    const int gw = F.vcu * NWAVES + F.wave, NGW = F.G * NWAVES;
    for (int task = gw; task < 4 * (M / 32); task += NGW) {
        const int j = task & 3, strip = task >> 2, t0 = strip * 32, bs = t0 & ~(SEQ - 1), W = 2 << j;
        const int col = 256 * j + 4 * F.lane;
        const f32x4 gv = *(const f32x4*)(gmix + col);
        f32x4 ring[16];
#pragma unroll
        for (int k = 0; k < 15; ++k) { const int tp = t0 - 15 + k; f32x4 hv = {0.f, 0.f, 0.f, 0.f};
            if (tp >= bs) { const float rs = row_rstd(ssq, tp); hv = *(const f32x4*)(xsrc + (size_t)tp * D + col) * rs * gv; }
            ring[(k + 1) & 15] = hv; }
#pragma unroll
        for (int i = 0; i < 32; ++i) { const int t = t0 + i; const float rs = row_rstd(ssq, t);
            const f32x4 hv = *(const f32x4*)(xsrc + (size_t)t * D + col) * rs * gv;
            ring[i & 15] = hv;
            f32x4 sum = hv;
#pragma unroll
            for (int k = 1; k < 16; ++k) if (k < W) sum += ring[(i - k) & 15];
            const int cnt = (t - bs + 1) < W ? (t - bs + 1) : W;
            const f32x4 u = sum * (1.0f / (float)cnt) - hv;
            u32x2 o; o.x = cvt_pk_bf16(u[0], u[1]); o.y = cvt_pk_bf16(u[2], u[3]);
            *(u32x2*)(upool + (size_t)t * D + col) = o; }
    }
}

__device__ __forceinline__ void phase_cmp2(Frame& F, const bf16* hid, const float* w2k, const float* w2v, const float* ropec, bf16* kc, bf16* vc) {
    const int gw = F.vcu * NWAVES + F.wave, NGW = F.G * NWAVES;
    for (int task = gw; task < 2 * 4096; task += NGW) {
        const int wh = task >> 12, row = task & 4095, c = row & 255, bg = row >> 8, b = bg >> 2, d = F.lane;
        const float* w2 = wh ? w2v : w2k; const bf16* hr = hid + ((size_t)wh * 4096 + row) * 128;
        float s = 0.f;
        for (int j = 0; j < 128; ++j) s += __uint_as_float(((unsigned)hr[j]) << 16) * w2[j * 64 + d];
        if (wh == 0) { const float partner = swz_xor<8>(s);
            if (d < 16) { const float cs = ropec[(b * 256 + c) * 16 + (d & 7)], sn = ropec[(b * 256 + c) * 16 + 8 + (d & 7)]; s = (d < 8) ? s * cs - partner * sn : s * cs + partner * sn; } }
        if (c == 255) s = 0.f;
        (wh ? vc : kc)[(size_t)row * 64 + d] = (bf16)f2bf(s);
    }
}

__device__ __forceinline__ void phase_final(Frame& F, float* x, const float* gfin) {
    const int gw = F.vcu * NWAVES + F.wave, NGW = F.G * NWAVES;
    for (int m = gw; m < M; m += NGW) { f32x4* xr = (f32x4*)(x + (size_t)m * D) + F.lane; f32x4 v[4]; float s = 0.f;
#pragma unroll
        for (int j = 0; j < 4; ++j) { v[j] = xr[64 * j]; s += (v[j][0] * v[j][0] + v[j][1] * v[j][1]) + (v[j][2] * v[j][2] + v[j][3] * v[j][3]); }
        const float rs = rsqrtf(wave_sum(s) * (1.0f / D) + EPS);
#pragma unroll
        for (int j = 0; j < 4; ++j) { const f32x4 gv = *((const f32x4*)gfin + F.lane + 64 * j); xr[64 * j] = v[j] * rs * gv; } }
}

enum PhaseKind { K_PRO = 0, K_PREP, K_POOLG, K_KVQ, K_CMP1, K_CMP2, K_ATT, K_WOUT, K_UP, K_DOWN, K_GATE, K_FINAL };
constexpr int NPHASES = 26;
#ifndef PH_MASK
#define PH_MASK 0xFFFF
#endif
#define PH_EN(k) (((PH_MASK) >> (k)) & 1)
__host__ __device__ __forceinline__ void decode_phase(int ph, int& kind, int& l) {
    if (ph == 0) { kind = K_PRO; l = 0; return; }
    if (ph >= 25) { kind = K_FINAL; l = 3; return; }
    int idx;
    if (ph < 6) { l = 0; idx = ph - 1; } else if (ph < 11) { l = 1; idx = ph - 6; } else if (ph < 19) { l = 2; idx = ph - 11; } else { l = 3; idx = ph - 19; }
    if (l < 2) { kind = idx == 0 ? K_PREP : idx == 1 ? K_POOLG : idx == 2 ? K_UP : idx == 3 ? K_DOWN : K_GATE; }
    else if (l == 2) { kind = idx == 0 ? K_KVQ : idx == 1 ? K_CMP1 : idx == 2 ? K_CMP2 : idx == 3 ? K_ATT : idx == 4 ? K_WOUT : idx == 5 ? K_UP : idx == 6 ? K_DOWN : K_GATE; }
    else { kind = idx == 0 ? K_KVQ : idx == 1 ? K_ATT : idx == 2 ? K_WOUT : idx == 3 ? K_UP : idx == 4 ? K_DOWN : K_GATE; }
}

struct CmpOrder {
    int c; const char* kvb; const char* wc1;
    __device__ __forceinline__ bool next(int i, pg8::Unit& u) const {
        if (i != 0 || c >= 32) return false;
        const int bg = c >> 1, which = c & 1, b = bg >> 2, g = bg & 3;
        u.pm = bg; u.pn = which; u.a = kvb + ((size_t)b * SEQ * NKV + which * 256 + g * 64) * 2; u.b = wc1 + (size_t)which * 256 * 2048 * 2; return true; }
    __device__ __forceinline__ void a_ready(const pg8::Unit&) const {}
    __device__ __forceinline__ void done(const pg8::Unit&) const {}
};

__global__ void __launch_bounds__(NWAVES * 64, 2) fwd_kernel(Args args) {
    extern __shared__ __attribute__((aligned(16))) unsigned char lds_raw[];
    LAS unsigned char* const lds0 = (LAS unsigned char*)lds_raw;
    volatile LAS unsigned* MISC = (volatile LAS unsigned*)(lds0 + MISC_OFF);
    const int wave_s = __builtin_amdgcn_readfirstlane((int)threadIdx.x >> 6);
    for (int u = threadIdx.x; u < (LDS_BYTES - LDSCTL_OFF) / 4; u += NWAVES * 64) ((LAS unsigned*)(lds0 + LDSCTL_OFF))[u] = 0u;
    __syncthreads();
    XcdBarrier bar; bar.bar = (unsigned*)((gu32*)(args.ws + WS_CTL) + CW_BAR); bar.x = 0; bar.st = nullptr;
    const int lo = args.ph_lo, hi = args.ph_hi;
    if (hi - lo > 1) bar = xcd_barrier_post((unsigned*)((gu32*)(args.ws + WS_CTL) + CW_BAR), MISC + 8);

    int ver = 0;
#define SSQ(v) ((float*)(ws + (((v) & 1) ? WS_SSQ1 : WS_SSQ0)))
    for (int ph = 0; ph < hi; ++ph) {
        int kind, l; decode_phase(ph, kind, l);
        const bool run = ph >= lo;
        if (run) {
            int bx_l = blockIdx.x; asm volatile("" : "+s"(bx_l));
            unsigned char* ws = args.ws; asm volatile("" : "+s"(ws));
            const int G_l = gridDim.x, vcu_l = (G_l % 8 == 0) ? (bx_l % 8) * (G_l / 8) + bx_l / 8 : bx_l;
#define FRESH_TID(name) int name; { int z_ = 0; asm volatile("" : "+v"(z_)); name = wave_s * 64 + (int)__builtin_amdgcn_mbcnt_hi(~0u, __builtin_amdgcn_mbcnt_lo(~0u, (unsigned)z_)); }
#define MAKE_FRAME(F, t) Frame F; F.lds = lds0; F.tid = (t); F.lane = (t) & 63; F.wave = wave_s; F.G = G_l; F.vcu = vcu_l; F.ws = ws;
            const float* x_in = (const float*)args.in[0]; float* X = args.out;
            bf16* XB = (bf16*)(ws + WS_XB); bf16* XBG = (bf16*)(ws + WS_XBG); bf16* PP = (bf16*)(ws + WS_PP); bf16* HB = (bf16*)(ws + WS_H);
            bf16* KVB = (bf16*)(ws + WS_KVB); bf16* QO = (bf16*)(ws + WS_QO); bf16* UPOOL = (bf16*)(ws + WS_UPOOL);
            const int cblk = bx_l;
            if (PH_EN(K_PRO) && kind == K_PRO) { FRESH_TID(t_) MAKE_FRAME(F, t_) phase_prologue(F, args); }
            if (PH_EN(K_PREP) && kind == K_PREP) { FRESH_TID(t_) MAKE_FRAME(F, t_) phase_poolprep(F, l == 0 ? x_in : (const float*)X, SSQ(ver), (const float*)args.in[3] + l * D, UPOOL); }
            if (PH_EN(K_POOLG) && (kind == K_POOLG || kind == K_KVQ)) {
                pg8::Gemm g{PLE, PLE, 128, 128, 4};
                pg8::GridOrder S{64, 4, G_l, cblk, (const char*)(ws + WS_PB) + (size_t)l * M * PLE * 2, (const char*)(ws + WS_WPP) + (size_t)l * D * PLE * 2, (size_t)256 * PLE * 2, 0, (size_t)256 * PLE * 2, 1 << 30, 0};
                EpiPP E{PP};
                { FRESH_TID(t_)
                pg8::gemm_phase<EpiPP, pg8::GridOrder, true, true>(lds0, g, S, E, t_); }
            }
            if (PH_EN(K_KVQ) && kind == K_KVQ) {
                const int nN = (l == 2) ? 11 : 5;
                pg8::Gemm g{D, D, 128, 128, 16};
                pg8::GridOrder S{64, nN, G_l, cblk, (const char*)XBG, (const char*)(ws + (l == 2 ? WS_WKVQ2 : WS_WQ3)), (size_t)256 * D * 2, 0, (size_t)256 * D * 2, 1 << 30, 0};
                EpiKVQ E{SSQ(ver), (const float*)(ws + WS_ROPE), KVB, QO, (float*)(ws + WS_GATES), (l == 2) ? 6 : 0};
                { FRESH_TID(t_)
                pg8::gemm_phase<EpiKVQ, pg8::GridOrder, true, true>(lds0, g, S, E, t_); }
            }
            if (PH_EN(K_CMP1) && kind == K_CMP1) {
                pg8::Gemm g{16 * NKV, 2048, NKV * 2, 128, 32};
                CmpOrder S{cblk, (const char*)KVB, (const char*)(ws + WS_WC1)};
                EpiCMP E{(const float*)(ws + WS_CB1), (bf16*)(ws + WS_HID)};
                { FRESH_TID(t_)
                pg8::gemm_phase<EpiCMP, CmpOrder, true, true>(lds0, g, S, E, t_); }
            }
            if (PH_EN(K_CMP2) && kind == K_CMP2) { FRESH_TID(t_) MAKE_FRAME(F, t_) phase_cmp2(F, (const bf16*)(ws + WS_HID), (const float*)args.in[10], (const float*)args.in[13], (const float*)(ws + WS_ROPEC), (bf16*)(ws + WS_KC), (bf16*)(ws + WS_VC)); }
            if (PH_EN(K_ATT) && kind == K_ATT) {
                att::Tensors T{QO, KVB, (const bf16*)(ws + WS_KC), (const bf16*)(ws + WS_VC), (const float*)(ws + WS_GATES), QO};
                const int bgi = (vcu_l >> 4) & 15, s = vcu_l & 15;
                for (int i = 0; i < 4; ++i) { const int qb = (i == 0) ? s : (i == 1) ? 31 - s : (i == 2) ? 32 + s : 63 - s;
                    FRESH_TID(t_) att::unit(T, bgi >> 2, bgi & 3, qb, (LAS char*)lds0, t_); }
            }
            if (PH_EN(K_DOWN) && (kind == K_POOLG || kind == K_WOUT || kind == K_DOWN)) {
                pg8::Gemm g; pg8::GridOrder S; S.nM = 64; S.nN = 4; S.G = G_l; S.c = cblk; S.pm_div = 1 << 30; S.b_pm = 0;
                const float* xold = X;
                if (kind == K_POOLG) { g = pg8::Gemm{D, 256, 128, 128, 4}; S.A = (const char*)UPOOL; S.a_tile = (size_t)256 * D * 2; S.a_pn = 512; S.B = (const char*)(ws + WS_WPOOL) + (size_t)l * D * 256 * 2; S.b_tile = (size_t)256 * 256 * 2; if (l == 0) xold = x_in; }
                else if (kind == K_WOUT) { g = pg8::Gemm{D, D, 128, 128, 16}; S.A = (const char*)QO; S.a_tile = (size_t)256 * D * 2; S.a_pn = 0; S.B = (const char*)(ws + WS_WOUT) + (size_t)(l - 2) * D * D * 2; S.b_tile = (size_t)256 * D * 2; }
                else { g = pg8::Gemm{FF, FF, 128, 128, 44}; S.A = (const char*)HB; S.a_tile = (size_t)256 * FF * 2; S.a_pn = 0; S.B = (const char*)(ws + WS_WDN) + (size_t)l * D * FF * 2; S.b_tile = (size_t)256 * FF * 2; }
                EpiX<0> E{xold, X, XB, SSQ(ver + 1), nullptr, nullptr};
                { FRESH_TID(t_)
                pg8::gemm_phase<EpiX<0>, pg8::GridOrder, false, true>(lds0, g, S, E, t_); }
            }
            if (PH_EN(K_UP) && kind == K_UP) {
                pg8::Gemm g{D, D, 128, 128, 16};
                EpiUP E{SSQ(ver), (const float*)args.in[18] + (size_t)l * 3 * FF2, (const float*)args.in[19] + (size_t)l * FF2, HB};
                for (int i = 0;; ++i) {
                    int pm, pn; if (!pg8::tile_order(NUPM, 22, G_l, cblk, i, pm, pn)) break;
                    pg8::OneUnit S; S.valid = true; S.u.pm = pm; S.u.pn = pn;
                    S.u.a = (const char*)XB + ((long)UPM * pm - 2) * (long)(D * 2); S.u.b = (const char*)(ws + WS_WUP) + ((size_t)l * FF2 + (size_t)pn * 256) * D * 2;
                    { FRESH_TID(t_)
                    pg8::gemm_phase<EpiUP, pg8::OneUnit, false, true>(lds0, g, S, E, t_); }
                }
            }
            if (PH_EN(K_GATE) && kind == K_GATE) {
                pg8::Gemm g{D, D, 128, 128, 16};
                pg8::GridOrder S{64, 4, G_l, cblk, (const char*)XB, (const char*)(ws + WS_WG) + (size_t)l * D * D * 2, (size_t)256 * D * 2, 0, (size_t)256 * D * 2, 1 << 30, 0};
                EpiX<1> E{X, X, XBG, SSQ(ver + 1), SSQ(ver), PP};
                { FRESH_TID(t_)
                pg8::gemm_phase<EpiX<1>, pg8::GridOrder, false, true>(lds0, g, S, E, t_); }
            }
            if (PH_EN(K_FINAL) && kind == K_FINAL) { FRESH_TID(t_) MAKE_FRAME(F, t_) phase_final(F, X, (const float*)args.in[24]); }
            if (ph + 1 < hi) { XcdBarrier b2 = bar; asm volatile("" : "+s"(b2.bar)); xcd_barrier(b2); }
        }
        if (kind == K_POOLG || kind == K_WOUT || kind == K_DOWN || kind == K_GATE) ++ver;
    }
}

extern "C" void kernel_launch(void* const* d_in, const int* in_sizes, int n_in, void* d_out, int out_size, void* d_ws, size_t ws_size, hipStream_t stream) {
    static int grid = 0;
    if (grid == 0) {
        if (n_in != 25 || out_size != M * D || ws_size < WS_END) { fprintf(stderr, "kernel_launch: unexpected shapes (n_in %d, out %d, ws %zu < %zu); nothing launched\n", n_in, out_size, ws_size, (size_t)WS_END); grid = -1; return; }
        int dev = 0, cus = 0, per_cu = 0;
        if (hipGetDevice(&dev) != hipSuccess || hipDeviceGetAttribute(&cus, hipDeviceAttributeMultiprocessorCount, dev) != hipSuccess) { grid = -1; return; }
        if (hipFuncSetAttribute((const void*)fwd_kernel, hipFuncAttributeMaxDynamicSharedMemorySize, LDS_BYTES) != hipSuccess) { fprintf(stderr, "kernel_launch: hipFuncSetAttribute failed\n"); grid = -1; return; }
        if (hipOccupancyMaxActiveBlocksPerMultiprocessor(&per_cu, (const void*)fwd_kernel, NWAVES * 64, LDS_BYTES) != hipSuccess || per_cu < 1) fprintf(stderr, "kernel_launch: occupancy query reports %d\n", per_cu);
        (void)hipGetLastError();
        grid = 256;
        if (cus != 256) fprintf(stderr, "kernel_launch: device has %d CUs, kernel is built for 256\n", cus);
    }
    if (grid < 0) return;
    if (hipMemsetAsync((char*)d_ws + WS_CTL, 0, CTL_ZERO_BYTES, stream) != hipSuccess) return;
    Args a{};
    for (int i = 0; i < 25; ++i) a.in[i] = d_in[i];
    a.out = (float*)d_out; a.ws = (unsigned char*)d_ws;
#if MK_PER_PHASE
    for (int ph = 0; ph < NPHASES; ++ph) { a.ph_lo = ph; a.ph_hi = ph + 1; hipLaunchKernelGGL(fwd_kernel, dim3(grid), dim3(NWAVES * 64), LDS_BYTES, stream, a); }
#else
    a.ph_lo = 0; a.ph_hi = NPHASES;
    hipLaunchKernelGGL(fwd_kernel, dim3(grid), dim3(NWAVES * 64), LDS_BYTES, stream, a);
#endif
}
```

```cpp
#include <hip/hip_runtime.h>
#include <hip/hip_bf16.h>
#include <cstdio>
#include <cstdint>
#include <cmath>

#ifndef MK_PER_PHASE
#define MK_PER_PHASE 0
#endif

namespace pg8 {
#define PG8_LAS __attribute__((address_space(3)))
typedef unsigned short bf16_t;
typedef short bf16x8 __attribute__((ext_vector_type(8)));
typedef float f32x4 __attribute__((ext_vector_type(4)));
typedef unsigned u32x4 __attribute__((ext_vector_type(4)));
typedef unsigned u32x2 __attribute__((ext_vector_type(2)));
constexpr int BM = 256, BK = 64, HALF = 128, HTB = HALF * BK * 2, STAGE_BYTES = 8 * HTB, NXCD = 8, WGM = 8;

__host__ __device__ __forceinline__ int lds_byte(int r, int c) { const int st = (r >> 4) * 2 + (c >> 5), rr = r & 15, cc = c & 31, ob = rr * 64 + cc * 2; return st * 1024 + (ob ^ (((ob >> 9) & 1) << 5)); }
__host__ __device__ __forceinline__ void stage_rc(int b, int& R, int& C) { const int st = b / 1024, sb = b % 1024, swz = sb ^ (((sb >> 9) & 1) << 5); R = (st >> 1) * 16 + swz / 64; C = (st & 1) * 32 + (swz % 64) / 2; }
__host__ __device__ __forceinline__ int perm32(int rho) { const int n = rho >> 4, i = rho & 15; return 8 * (i >> 2) + 4 * n + (i & 3); }

struct Unit { int pm, pn; const char* a; const char* b; };
struct Gemm { int lda, ldb; int kstepA, kstepB; int nt; };

__device__ __forceinline__ bool tile_order(int nM, int nN, int G, int c, int i, int& pm, int& pn) {
    const int nwg = nM * nN; const long L = (long)i * G + c; if (L >= nwg) return false;
    int wgid = (int)L; { const int q = nwg / NXCD, r = nwg % NXCD, xcd = wgid % NXCD, off = wgid / NXCD; wgid = (xcd < r ? xcd * (q + 1) : r * (q + 1) + (xcd - r) * q) + off; }
    const int nig = WGM * nN, gid = wgid / nig, fm = gid * WGM, gsz = (nM - fm) < WGM ? (nM - fm) : WGM;
    pm = fm + ((wgid % nig) % gsz); pn = (wgid % nig) / gsz; return true;
}
struct GridOrder {
    int nM, nN, G, c; const char* A; const char* B; size_t a_tile, a_pn, b_tile; int pm_div; size_t b_pm;
    __device__ __forceinline__ bool next(int i, Unit& u) const {
        int pm, pn; if (!tile_order(nM, nN, G, c, i, pm, pn)) return false;
        u.pm = pm; u.pn = pn; u.a = A + (size_t)pm * a_tile + (size_t)pn * a_pn; u.b = B + (size_t)pn * b_tile + (size_t)(pm / pm_div) * b_pm; return true; }
    __device__ __forceinline__ void a_ready(const Unit&) const {}
    __device__ __forceinline__ void done(const Unit&) const {}
};
struct OneUnit { Unit u; bool valid;
    __device__ __forceinline__ bool next(int i, Unit& o) const { if (i != 0 || !valid) return false; o = u; return true; }
    __device__ __forceinline__ void a_ready(const Unit&) const {}
    __device__ __forceinline__ void done(const Unit&) const {}
};
__device__ __forceinline__ unsigned cvt_pk_bf16(float lo, float hi) { unsigned r; asm volatile("v_cvt_pk_bf16_f32 %0, %1, %2" : "=v"(r) : "v"(lo), "v"(hi)); return r; }
__device__ __forceinline__ float bf_lo(unsigned w) { return __uint_as_float(w << 16); }
__device__ __forceinline__ float bf_hi(unsigned w) { return __uint_as_float(w & 0xffff0000u); }
__device__ __forceinline__ float sigmoidf_(float v) { return 1.0f / (1.0f + __expf(-v)); }

template <class Epi, class Sched, bool ALIGN_EPI = false, bool SP2 = false>
__device__ __forceinline__ void gemm_phase(PG8_LAS unsigned char* lds, const Gemm g, const Sched& S, const Epi& E, const int tid) {
    const int wid = __builtin_amdgcn_readfirstlane(tid >> 6), lane = tid & 63, wr = wid >> 2, wc = wid & 3, fr = lane & 15, fq = lane >> 4;
    const int nt = g.nt;
    unsigned voffA[2], voffB[2];
#pragma unroll
    for (int i = 0; i < 2; ++i) { int R, C; stage_rc(tid * 16 + i * 8192, R, C); const int Rb = Epi::PERM ? ((R & ~31) + perm32(R & 31)) : R;
        voffA[i] = (unsigned)(R * g.lda + C) * 2u; voffB[i] = (unsigned)(Rb * g.ldb + C) * 2u; }
    const unsigned kstepA = (unsigned)g.kstepA, kstepB = (unsigned)g.kstepB;
    const unsigned hstepA = (unsigned)(HALF * g.lda * 2), hstepB = (unsigned)(HALF * g.ldb * 2);
    const unsigned ldsw = (unsigned)wid * 1024u;
    const int aoff = lds_byte(wr * 64 + fr, fq * 8), boff = lds_byte(wc * 32 + fr, fq * 8);
#define PG8_SA(b, h) (((b) * 2 + (h)) * HTB)
#define PG8_SB(b, h) ((4 + (b) * 2 + (h)) * HTB)
#define PG8_STAGE(bufoff, gbase, voff) do { _Pragma("unroll") for (int _i = 0; _i < 2; ++_i) \
        __builtin_amdgcn_global_load_lds((const unsigned*)((const char*)(gbase) + (voff)[_i]), (PG8_LAS unsigned*)(lds + (bufoff) + ldsw + _i * 8192), 16, 0, 0); } while (0)
#define PG8_LDA(dst, b, h) do { _Pragma("unroll") for (int m = 0; m < 4; ++m) _Pragma("unroll") for (int k = 0; k < 2; ++k) dst[m][k] = *(const PG8_LAS bf16x8*)(lds + PG8_SA(b, h) + aoff + m * 2048 + k * 1024); } while (0)
#define PG8_LDB(dst, b, h) do { _Pragma("unroll") for (int n = 0; n < 2; ++n) _Pragma("unroll") for (int k = 0; k < 2; ++k) dst[n][k] = *(const PG8_LAS bf16x8*)(lds + PG8_SB(b, h) + boff + n * 2048 + k * 1024); } while (0)
#define PG8_MMA(ai, bj, At, Bt) do { __builtin_amdgcn_s_setprio(1); _Pragma("unroll") for (int m = 0; m < 4; ++m) _Pragma("unroll") for (int n = 0; n < 2; ++n) _Pragma("unroll") for (int k = 0; k < 2; ++k) \
        acc[ai][bj][m][n] = __builtin_amdgcn_mfma_f32_16x16x32_bf16(Bt[n][k], At[m][k], acc[ai][bj][m][n], 0, 0, 0); __builtin_amdgcn_s_setprio(0); } while (0)
#define PG8_WAIT_V(n) asm volatile("s_waitcnt vmcnt(" #n ")" ::: "memory")
#define PG8_WAIT_L(n) asm volatile("s_waitcnt lgkmcnt(" #n ")" ::: "memory")
#define PG8_BAR __builtin_amdgcn_s_barrier()
#define PG8_SCHED __builtin_amdgcn_sched_barrier(0)
    Unit cur, nxt; int ui = 0;
    if (!S.next(0, cur)) return;
    f32x4 acc[2][2][4][2];
#pragma unroll
    for (int a = 0; a < 2; ++a)
#pragma unroll
        for (int b = 0; b < 2; ++b)
#pragma unroll
            for (int m = 0; m < 4; ++m)
#pragma unroll
                for (int n = 0; n < 2; ++n) acc[a][b][m][n] = (f32x4){0.f, 0.f, 0.f, 0.f};
    bf16x8 At[4][2], B0[2][2], B1[2][2];
    const char* cA = cur.a; const char* cB = cur.b;
    S.a_ready(cur);
    if constexpr (SP2) {
        PG8_STAGE(PG8_SB(0, 0), cB, voffB); PG8_STAGE(PG8_SB(0, 1), cB + hstepB, voffB); PG8_STAGE(PG8_SA(0, 0), cA, voffA); PG8_STAGE(PG8_SA(0, 1), cA + hstepA, voffA);
        if (wr == 1) PG8_BAR;
        PG8_WAIT_V(2); PG8_BAR;
        PG8_STAGE(PG8_SB(1, 0), cB + kstepB, voffB); PG8_STAGE(PG8_SA(1, 0), cA + kstepA, voffA); PG8_STAGE(PG8_SB(1, 1), cB + hstepB + kstepB, voffB);
        PG8_WAIT_V(6); PG8_BAR;
    } else {
        PG8_STAGE(PG8_SB(0, 0), cB, voffB); PG8_STAGE(PG8_SA(0, 0), cA, voffA); PG8_STAGE(PG8_SB(0, 1), cB + hstepB, voffB); PG8_STAGE(PG8_SA(0, 1), cA + hstepA, voffA);
        if (wr == 1) PG8_BAR;
        PG8_WAIT_V(4); PG8_BAR;
        PG8_STAGE(PG8_SB(1, 0), cB + kstepB, voffB); PG8_STAGE(PG8_SA(1, 0), cA + kstepA, voffA); PG8_STAGE(PG8_SB(1, 1), cB + hstepB + kstepB, voffB);
        PG8_WAIT_V(6); PG8_BAR;
    }
    for (;;) {
        const bool has_next = S.next(ui + 1, nxt);
        const char* nA = has_next ? nxt.a : cA; const char* nB = has_next ? nxt.b : cB;
        for (int t = 0; t < nt; t += 2) {
            const bool last = (t == nt - 2);
            const char* a1 = cA + (size_t)((unsigned)(t + 1) * kstepA);
            const char* a2 = last ? nA : cA + (size_t)((unsigned)(t + 2) * kstepA); const char* b2 = last ? nB : cB + (size_t)((unsigned)(t + 2) * kstepB);
            const char* a3 = a2 + kstepA; const char* b3 = b2 + kstepB;
            if (last && has_next) S.a_ready(nxt);
            if constexpr (SP2) {
            PG8_LDB(B0, 0, 0); PG8_LDB(B1, 0, 1); PG8_SCHED; PG8_LDA(At, 0, 0); PG8_STAGE(PG8_SA(1, 1), a1 + hstepA, voffA);
            PG8_WAIT_V(8); PG8_WAIT_L(0); PG8_BAR; PG8_MMA(0, 0, At, B0); PG8_MMA(0, 1, At, B1); PG8_BAR; PG8_SCHED;
            PG8_LDA(At, 0, 1); PG8_STAGE(PG8_SB(0, 0), b2, voffB); PG8_STAGE(PG8_SB(0, 1), b2 + hstepB, voffB); PG8_STAGE(PG8_SA(0, 0), a2, voffA);
            PG8_WAIT_V(8); PG8_WAIT_L(0); PG8_BAR; PG8_MMA(1, 0, At, B0); PG8_MMA(1, 1, At, B1); PG8_BAR; PG8_SCHED;
            PG8_LDB(B0, 1, 0); PG8_LDB(B1, 1, 1); PG8_SCHED; PG8_LDA(At, 1, 0); PG8_STAGE(PG8_SA(0, 1), a2 + hstepA, voffA);
            PG8_WAIT_V(8); PG8_WAIT_L(0); PG8_BAR; PG8_MMA(0, 0, At, B0); PG8_MMA(0, 1, At, B1); PG8_BAR; PG8_SCHED;
            PG8_LDA(At, 1, 1); PG8_STAGE(PG8_SB(1, 0), b3, voffB); PG8_STAGE(PG8_SB(1, 1), b3 + hstepB, voffB); PG8_STAGE(PG8_SA(1, 0), a3, voffA);
            PG8_WAIT_V(8); PG8_WAIT_L(0); PG8_BAR; PG8_MMA(1, 0, At, B0); PG8_MMA(1, 1, At, B1); PG8_BAR; PG8_SCHED;
            } else {
            PG8_LDB(B0, 0, 0); PG8_SCHED; PG8_LDA(At, 0, 0); PG8_STAGE(PG8_SA(1, 1), a1 + hstepA, voffA);
            PG8_WAIT_L(8); PG8_BAR; PG8_WAIT_L(0); PG8_MMA(0, 0, At, B0); PG8_BAR; PG8_SCHED;
            PG8_LDB(B1, 0, 1); PG8_STAGE(PG8_SB(0, 0), b2, voffB);
            PG8_BAR; PG8_WAIT_L(0); PG8_MMA(0, 1, At, B1); PG8_BAR;
            PG8_LDA(At, 0, 1); PG8_STAGE(PG8_SA(0, 0), a2, voffA);
            PG8_BAR; PG8_WAIT_L(0); PG8_MMA(1, 0, At, B0); PG8_BAR; PG8_SCHED;
            PG8_STAGE(PG8_SB(0, 1), b2 + hstepB, voffB);
            PG8_WAIT_V(6); PG8_BAR; PG8_MMA(1, 1, At, B1); PG8_BAR;
            PG8_LDB(B0, 1, 0); PG8_SCHED; PG8_LDA(At, 1, 0); PG8_STAGE(PG8_SA(0, 1), a2 + hstepA, voffA);
            PG8_WAIT_L(8); PG8_BAR; PG8_WAIT_L(0); PG8_MMA(0, 0, At, B0); PG8_BAR; PG8_SCHED;
            PG8_LDB(B1, 1, 1); PG8_STAGE(PG8_SB(1, 0), b3, voffB);
            PG8_BAR; PG8_WAIT_L(0); PG8_MMA(0, 1, At, B1); PG8_BAR;
            PG8_LDA(At, 1, 1); PG8_STAGE(PG8_SA(1, 0), a3, voffA);
            PG8_BAR; PG8_WAIT_L(0); PG8_MMA(1, 0, At, B0); PG8_BAR; PG8_SCHED;
            PG8_STAGE(PG8_SB(1, 1), b3 + hstepB, voffB);
            PG8_WAIT_V(6); PG8_BAR; PG8_MMA(1, 1, At, B1); PG8_BAR;
            }
        }
        if constexpr (ALIGN_EPI) { if (wr == 0) PG8_BAR; }
        if constexpr (!Epi::AFTER_DRAIN) { int z_e = 0; asm volatile("" : "+v"(z_e)); const int lane_e = (int)__builtin_amdgcn_mbcnt_hi(~0u, __builtin_amdgcn_mbcnt_lo(~0u, (unsigned)z_e)); const int fr_e = lane_e & 15, fq_e = lane_e >> 4; E(acc, cur, wr, wc, fr_e, fq_e); S.done(cur); }
        if (!has_next) break;
#pragma unroll
        for (int a = 0; a < 2; ++a)
#pragma unroll
            for (int b = 0; b < 2; ++b)
#pragma unroll
                for (int m = 0; m < 4; ++m)
#pragma unroll
                    for (int n = 0; n < 2; ++n) acc[a][b][m][n] = (f32x4){0.f, 0.f, 0.f, 0.f};
        cur = nxt; cA = nA; cB = nB; ++ui;
        if constexpr (ALIGN_EPI) { if (wr == 1) PG8_BAR; }
    }
    PG8_WAIT_V(0);
    if constexpr (!ALIGN_EPI) { if (wr == 0) PG8_BAR; }
    PG8_BAR;
    if constexpr (Epi::AFTER_DRAIN) { int z_e = 0; asm volatile("" : "+v"(z_e)); const int lane_e = (int)__builtin_amdgcn_mbcnt_hi(~0u, __builtin_amdgcn_mbcnt_lo(~0u, (unsigned)z_e)); const int fr_e = lane_e & 15, fq_e = lane_e >> 4; E.fused(acc, cur, wr, wc, fr_e, fq_e, lds, wid, lane_e); S.done(cur); }
#undef PG8_SA
#undef PG8_SB
#undef PG8_STAGE
#undef PG8_LDA
#undef PG8_LDB
#undef PG8_MMA
#undef PG8_WAIT_V
#undef PG8_WAIT_L
#undef PG8_BAR
#undef PG8_SCHED
}

}

constexpr int M = 16384, D = 1024, SEQ = 4096, NBATCH = 4, DEPTH = 4, FF = 2816, FF2 = 5632, PLE = 256;
constexpr int NKV = 1536, NQC = 1072;
constexpr float EPS = 1e-6f;
constexpr float QSCALE = 0.125f * 1.4426950408889634f;
constexpr int UPM = 254;
constexpr int NUPM = (M + UPM - 1) / UPM;
constexpr int TPITCH = 264;

#define GAS __attribute__((address_space(1)))
#define LAS __attribute__((address_space(3)))
typedef unsigned short bf16;
typedef float f32x4 __attribute__((ext_vector_type(4)));
typedef float f32x16 __attribute__((ext_vector_type(16)));
typedef short bf16x8 __attribute__((ext_vector_type(8)));
typedef short s16x4 __attribute__((ext_vector_type(4)));
typedef unsigned u32x4 __attribute__((ext_vector_type(4)));
typedef unsigned u32x2 __attribute__((ext_vector_type(2)));
using pg8::cvt_pk_bf16; using pg8::bf_lo; using pg8::bf_hi; using pg8::sigmoidf_;


template <int MASK> __device__ __forceinline__ float swz_xor(float v) { return __uint_as_float((unsigned)__builtin_amdgcn_ds_swizzle((int)__float_as_uint(v), 0x1F | (MASK << 10))); }
template <int MASK> __device__ __forceinline__ unsigned swz_xor_u(unsigned v) { return (unsigned)__builtin_amdgcn_ds_swizzle((int)v, 0x1F | (MASK << 10)); }
__device__ __forceinline__ float xor32_sum(float v) { auto rr = __builtin_amdgcn_permlane32_swap(__float_as_uint(v), __float_as_uint(v), false, false); return __uint_as_float(rr[0]) + __uint_as_float(rr[1]); }
__device__ __forceinline__ float xor32_max(float v) { auto rr = __builtin_amdgcn_permlane32_swap(__float_as_uint(v), __float_as_uint(v), false, false); return fmaxf(__uint_as_float(rr[0]), __uint_as_float(rr[1])); }
__device__ __forceinline__ float xor32_other(float v, int hi) { auto rr = __builtin_amdgcn_permlane32_swap(__float_as_uint(v), __float_as_uint(v), false, false); return __uint_as_float(hi ? rr[0] : rr[1]); }

__device__ __forceinline__ float row_rstd(const float* ssq, int row) {
    const f32x4 s = *(const f32x4*)(ssq + 4 * (size_t)row);
    return rsqrtf(((s[0] + s[1]) + (s[2] + s[3])) * (1.0f / 1024.0f) + EPS);
}
#define WG_BAR() do { asm volatile("s_waitcnt vmcnt(0) lgkmcnt(0)" ::: "memory"); __builtin_amdgcn_s_barrier(); asm volatile("" ::: "memory"); } while (0)

template <int MODE> struct EpiX {
    static constexpr bool PERM = false, AFTER_DRAIN = true;
    const float* xold; float* xnew; bf16* xb; float* ssq_out; const float* ssq_in; const bf16* pp;
    __device__ __forceinline__ void fused(pg8::f32x4 (&acc)[2][2][4][2], const pg8::Unit& u, int wr, int wc, int fr, int fq, PG8_LAS unsigned char* lds, int wid, int lane) const {
        LAS float* P = (LAS float*)lds;
        const int col0 = u.pn * 256 + wc * 32 + 4 * fq;
#pragma unroll
        for (int ai = 0; ai < 2; ++ai)
#pragma unroll
            for (int m = 0; m < 4; ++m) {
                const int r = ai * 128 + wr * 64 + m * 16 + fr, grow = u.pm * 256 + r; const size_t off = (size_t)grow * D + col0;
                float rs = 0.f; if (MODE == 1) rs = row_rstd(ssq_in, grow);
                float sq = 0.f;
#pragma unroll
                for (int bj = 0; bj < 2; ++bj)
#pragma unroll
                    for (int n = 0; n < 2; ++n) {
                        const size_t c = off + bj * 128 + n * 16;
                        f32x4 v = acc[ai][bj][m][n];
                        if (MODE == 1) { const u32x2 w = *(const u32x2*)(pp + c);
                            v[0] = sigmoidf_(rs * v[0]) * bf_lo(w.x); v[1] = sigmoidf_(rs * v[1]) * bf_hi(w.x); v[2] = sigmoidf_(rs * v[2]) * bf_lo(w.y); v[3] = sigmoidf_(rs * v[3]) * bf_hi(w.y); }
                        const f32x4 xo = *(const f32x4*)(xold + c); const f32x4 xn = xo + v;
                        *(f32x4*)(xnew + c) = xn;
                        u32x2 o; o.x = cvt_pk_bf16(xn[0], xn[1]); o.y = cvt_pk_bf16(xn[2], xn[3]); *(u32x2*)(xb + c) = o;
                        sq += (xn[0] * xn[0] + xn[1] * xn[1]) + (xn[2] * xn[2] + xn[3] * xn[3]);
                    }
                sq += swz_xor<16>(sq); sq = xor32_sum(sq);
                if (fq == 0) P[r * 4 + wc] = sq;
            }
        WG_BAR();
        const int tid = wid * 64 + lane;
        if (tid < 256) { const float s = (P[tid * 4 + 0] + P[tid * 4 + 1]) + (P[tid * 4 + 2] + P[tid * 4 + 3]); ssq_out[(size_t)(u.pm * 256 + tid) * 4 + u.pn] = s; }
        WG_BAR();
    }
};

struct EpiPP {
    static constexpr bool PERM = true, AFTER_DRAIN = false;
    bf16* O;
    __device__ __forceinline__ void operator()(const pg8::f32x4 (&acc)[2][2][4][2], const pg8::Unit& u, int wr, int wc, int fr, int fq) const {
        const int row0 = u.pm * 256 + wr * 64 + fr, col0 = u.pn * 256 + wc * 32 + 8 * fq;
#pragma unroll
        for (int ai = 0; ai < 2; ++ai)
#pragma unroll
            for (int m = 0; m < 4; ++m) { bf16* rowp = O + (size_t)(row0 + ai * 128 + m * 16) * D + col0;
#pragma unroll
                for (int bj = 0; bj < 2; ++bj) { const f32x4 v0 = acc[ai][bj][m][0], v1 = acc[ai][bj][m][1];
                    u32x4 w; w.x = cvt_pk_bf16(v0[0], v0[1]); w.y = cvt_pk_bf16(v0[2], v0[3]); w.z = cvt_pk_bf16(v1[0], v1[1]); w.w = cvt_pk_bf16(v1[2], v1[3]);
                    *(u32x4*)(rowp + bj * 128) = w; } }
    }
};

struct EpiKVQ {
    static constexpr bool PERM = true, AFTER_DRAIN = false;
    const float* ssq_in; const float* rope;
    bf16* kvb; bf16* qb; float* gates; int n_kv;
    __device__ __forceinline__ void operator()(const pg8::f32x4 (&acc)[2][2][4][2], const pg8::Unit& u, int wr, int wc, int fr, int fq) const {
        const int pn = u.pn; const int kind = pn < n_kv ? 0 : (pn < n_kv + 4 ? 1 : 2);
        const bool roped = (kind == 1) || (kind == 0 && (pn == 2 || pn == 4));
        const bool rope_wave = roped && ((wc & 1) == 0);
        const float sgn = (fq == 0) ? -1.f : 1.f;
#pragma unroll
        for (int ai = 0; ai < 2; ++ai)
#pragma unroll
            for (int m = 0; m < 4; ++m) {
                const int grow = u.pm * 256 + ai * 128 + wr * 64 + m * 16 + fr;
                const float rs = row_rstd(ssq_in, grow);
                f32x4 cs0 = {1.f, 1.f, 1.f, 1.f}, cs1 = cs0, sn0 = {0.f, 0.f, 0.f, 0.f}, sn1 = sn0;
                if (rope_wave && fq < 2) { const f32x4* rp = (const f32x4*)(rope + (size_t)grow * 16); cs0 = rp[0]; cs1 = rp[1]; sn0 = rp[2]; sn1 = rp[3]; }
#pragma unroll
                for (int bj = 0; bj < 2; ++bj) {
                    f32x4 v0 = acc[ai][bj][m][0] * rs, v1 = acc[ai][bj][m][1] * rs;
                    if (rope_wave) {
                        f32x4 p0, p1;
#pragma unroll
                        for (int e = 0; e < 4; ++e) { p0[e] = swz_xor<16>(v0[e]); p1[e] = swz_xor<16>(v1[e]); }
                        if (fq < 2) { v0 = v0 * cs0 + (p0 * sn0) * sgn; v1 = v1 * cs1 + (p1 * sn1) * sgn; }
                    }
                    const int cl = bj * 128 + wc * 32 + 8 * fq;
                    if (kind == 2) {
                        if (cl < 48) { float* g = gates + (size_t)grow * 48 + cl;
                            f32x4 a, b;
#pragma unroll
                            for (int e = 0; e < 4; ++e) { a[e] = sigmoidf_(v0[e]); b[e] = sigmoidf_(v1[e]); }
                            *(f32x4*)g = a; *(f32x4*)(g + 4) = b; }
                    } else {
                        if (kind == 1) { v0 = v0 * QSCALE; v1 = v1 * QSCALE; }
                        u32x4 w; w.x = cvt_pk_bf16(v0[0], v0[1]); w.y = cvt_pk_bf16(v0[2], v0[3]); w.z = cvt_pk_bf16(v1[0], v1[1]); w.w = cvt_pk_bf16(v1[2], v1[3]);
                        bf16* dst = (kind == 0) ? kvb + (size_t)grow * NKV + pn * 256 + cl : qb + (size_t)grow * D + (pn - n_kv) * 256 + cl;
                        *(u32x4*)dst = w;
                    }
                }
            }
    }
};

struct EpiCMP {
    static constexpr bool PERM = true, AFTER_DRAIN = false;
    const float* bias1;
    bf16* hid;
    __device__ __forceinline__ void operator()(const pg8::f32x4 (&acc)[2][2][4][2], const pg8::Unit& u, int wr, int wc, int fr, int fq) const {
        const int which = u.pn; const int cl = wc * 32 + 8 * fq;
        const f32x4 b0 = *(const f32x4*)(bias1 + which * 128 + cl), b1 = *(const f32x4*)(bias1 + which * 128 + cl + 4);
#pragma unroll
        for (int ai = 0; ai < 2; ++ai)
#pragma unroll
            for (int m = 0; m < 4; ++m) {
                const int row = u.pm * 256 + ai * 128 + wr * 64 + m * 16 + fr;
                f32x4 v0 = acc[ai][0][m][0] + b0, v1 = acc[ai][0][m][1] + b1;
#pragma unroll
                for (int e = 0; e < 4; ++e) {
                    { const float x = v0[e]; const float y = 0.7978845608028654f * (x + 0.044715f * x * x * x); v0[e] = x / (1.0f + __expf(-2.0f * y)); }
                    { const float x = v1[e]; const float y = 0.7978845608028654f * (x + 0.044715f * x * x * x); v1[e] = x / (1.0f + __expf(-2.0f * y)); }
                }
                u32x4 w; w.x = cvt_pk_bf16(v0[0], v0[1]); w.y = cvt_pk_bf16(v0[2], v0[3]); w.z = cvt_pk_bf16(v1[0], v1[1]); w.w = cvt_pk_bf16(v1[2], v1[3]);
                *(u32x4*)(hid + ((size_t)which * 4096 + row) * 128 + cl) = w;
            }
    }
};

struct EpiUP {
    static constexpr bool PERM = true, AFTER_DRAIN = true;
    const float* ssq_in; const float* convw; const float* convb;
    bf16* h;
    __device__ __forceinline__ void fused(pg8::f32x4 (&acc)[2][2][4][2], const pg8::Unit& u, int wr, int wc, int fr, int fq, PG8_LAS unsigned char* lds, int wid, int lane) const {
        LAS bf16* T = (LAS bf16*)lds;
        const int rbase = UPM * u.pm - 2;
#pragma unroll
        for (int ai = 0; ai < 2; ++ai)
#pragma unroll
            for (int m = 0; m < 4; ++m) {
                const int rl = ai * 128 + wr * 64 + m * 16 + fr; int grow = rbase + rl; grow = grow < 0 ? 0 : (grow >= M ? M - 1 : grow);
                const float rs = row_rstd(ssq_in, grow);
#pragma unroll
                for (int bj = 0; bj < 2; ++bj) { const f32x4 v0 = acc[ai][bj][m][0] * rs, v1 = acc[ai][bj][m][1] * rs;
                    u32x4 w; w.x = cvt_pk_bf16(v0[0], v0[1]); w.y = cvt_pk_bf16(v0[2], v0[3]); w.z = cvt_pk_bf16(v1[0], v1[1]); w.w = cvt_pk_bf16(v1[2], v1[3]);
                    *(LAS u32x4*)(T + rl * TPITCH + bj * 128 + wc * 32 + 8 * fq) = w; }
            }
        WG_BAR();
        const int tid = wid * 64 + lane, c8 = tid & 15, rsub = tid >> 4;
        const int hc = u.pn * 128 + c8 * 8;
        float wa[3][8], wg[3][8], ba[8], bg[8];
#pragma unroll
        for (int t = 0; t < 3; ++t) {
            const f32x4 a0 = *(const f32x4*)(convw + t * FF2 + hc), a1 = *(const f32x4*)(convw + t * FF2 + hc + 4);
            const f32x4 g0 = *(const f32x4*)(convw + t * FF2 + FF + hc), g1 = *(const f32x4*)(convw + t * FF2 + FF + hc + 4);
#pragma unroll
            for (int e = 0; e < 4; ++e) { wa[t][e] = a0[e]; wa[t][4 + e] = a1[e]; wg[t][e] = g0[e]; wg[t][4 + e] = g1[e]; }
        }
        { const f32x4 a0 = *(const f32x4*)(convb + hc), a1 = *(const f32x4*)(convb + hc + 4), g0 = *(const f32x4*)(convb + FF + hc), g1 = *(const f32x4*)(convb + FF + hc + 4);
#pragma unroll
          for (int e = 0; e < 4; ++e) { ba[e] = a0[e]; ba[4 + e] = a1[e]; bg[e] = g0[e]; bg[4 + e] = g1[e]; } }
        for (int p = 0; p < 8; ++p) {
            const int rl = p * 32 + rsub; const int grow = rbase + rl;
            if (rl >= 2 && grow < M) {
                const int t = grow & (SEQ - 1);
                const u32x4 z = {0u, 0u, 0u, 0u};
                const u32x4 a2 = *(const LAS u32x4*)(T + rl * TPITCH + c8 * 8), g2 = *(const LAS u32x4*)(T + rl * TPITCH + 128 + c8 * 8);
                u32x4 a1 = *(const LAS u32x4*)(T + (rl - 1) * TPITCH + c8 * 8), g1 = *(const LAS u32x4*)(T + (rl - 1) * TPITCH + 128 + c8 * 8);
                u32x4 a0 = *(const LAS u32x4*)(T + (rl - 2) * TPITCH + c8 * 8), g0 = *(const LAS u32x4*)(T + (rl - 2) * TPITCH + 128 + c8 * 8);
                if (t < 1) { a1 = z; g1 = z; }
                if (t < 2) { a0 = z; g0 = z; }
                float o[8];
#pragma unroll
                for (int e = 0; e < 4; ++e) {
                    const unsigned A0 = a0[e], A1 = a1[e], A2 = a2[e], G0 = g0[e], G1 = g1[e], G2 = g2[e];
                    const float al = ba[2 * e] + wa[0][2 * e] * bf_lo(A0) + wa[1][2 * e] * bf_lo(A1) + wa[2][2 * e] * bf_lo(A2);
                    const float ah = ba[2 * e + 1] + wa[0][2 * e + 1] * bf_hi(A0) + wa[1][2 * e + 1] * bf_hi(A1) + wa[2][2 * e + 1] * bf_hi(A2);
                    const float gl = bg[2 * e] + wg[0][2 * e] * bf_lo(G0) + wg[1][2 * e] * bf_lo(G1) + wg[2][2 * e] * bf_lo(G2);
                    const float gh = bg[2 * e + 1] + wg[0][2 * e + 1] * bf_hi(G0) + wg[1][2 * e + 1] * bf_hi(G1) + wg[2][2 * e + 1] * bf_hi(G2);
                    o[2 * e] = gl * sigmoidf_(gl) * al; o[2 * e + 1] = gh * sigmoidf_(gh) * ah;
                }
                u32x4 w; w.x = cvt_pk_bf16(o[0], o[1]); w.y = cvt_pk_bf16(o[2], o[3]); w.z = cvt_pk_bf16(o[4], o[5]); w.w = cvt_pk_bf16(o[6], o[7]);
                *(u32x4*)(h + (size_t)grow * FF + hc) = w;
            }
        }
        WG_BAR();
    }
};

namespace att {
constexpr int LDS_K = 0, LDS_V = 16384, LDS_WS = 32768, LDS_IMP = 40960, LDS_TOT = 106496, LDS_SEL = 122880;
constexpr float NEGF = -1e30f;
typedef const LAS char* lcp;
typedef short v4i16_t __attribute__((ext_vector_type(4)));
__device__ __forceinline__ s16x4 vtr(lcp p) { return __builtin_bit_cast(s16x4, __builtin_amdgcn_ds_read_tr16_b64_v4i16((LAS v4i16_t*)p)); }
__device__ __forceinline__ int crow(int r, int hi) { return (r & 3) + 8 * (r >> 2) + 4 * hi; }

struct Ctx {
    LAS char* lds; int wid, lane, r32, hi, tl;
    bf16x8 qr[4];
    float m, l; f32x16 o[2];
    float inv_l, carry; int hp;
};

__device__ __forceinline__ void load_tile_regs(const bf16* kb, const bf16* vb, int pitch, int tile, int wid, int lane, u32x4& kr, u32x4& vr) {
    kr = *(const u32x4*)(kb + (size_t)(tile * 64 + lane) * pitch + wid * 8);
    vr = *(const u32x4*)(vb + (size_t)(tile * 64 + 16 * (wid & 3) + (lane >> 2)) * pitch + (wid >> 2) * 32 + (lane & 3) * 8);
}
__device__ __forceinline__ void store_tile_lds(LAS char* lds, int slot, int wid, int lane, const u32x4& kr, const u32x4& vr) {
    *(LAS u32x4*)(lds + LDS_K + slot * 8192 + wid * 1024 + lane * 16) = kr;
    *(LAS u32x4*)(lds + LDS_V + slot * 8192 + wid * 1024 + lane * 16) = vr;
}
__device__ __forceinline__ void qkt(f32x16& p0, f32x16& p1, lcp kslot, const bf16x8* qr, int r32, int hi) {
    lcp kb = kslot + hi * 1024 + r32 * 16;
    f32x16 z;
#pragma unroll
    for (int r = 0; r < 16; ++r) z[r] = 0.f;
    p0 = z; p1 = z;
#pragma unroll
    for (int d0 = 0; d0 < 4; ++d0) {
        const bf16x8 b0 = *(const LAS bf16x8*)(kb + d0 * 2048);
        const bf16x8 b1 = *(const LAS bf16x8*)(kb + d0 * 2048 + 512);
        p0 = __builtin_amdgcn_mfma_f32_32x32x16_bf16(b0, qr[d0], p0, 0, 0, 0);
        p1 = __builtin_amdgcn_mfma_f32_32x32x16_bf16(b1, qr[d0], p1, 0, 0, 0);
    }
}
__device__ __forceinline__ bf16x8 pack8(const f32x16& p, int b) {
    u32x4 w; w.x = cvt_pk_bf16(p[b], p[b + 1]); w.y = cvt_pk_bf16(p[b + 2], p[b + 3]); w.z = cvt_pk_bf16(p[b + 4], p[b + 5]); w.w = cvt_pk_bf16(p[b + 6], p[b + 7]);
    return __builtin_bit_cast(bf16x8, w);
}
__device__ __forceinline__ void pv(f32x16* o, lcp vp, const f32x16& p0, const f32x16& p1) {
    const bf16x8 pa0 = pack8(p0, 0), pa1 = pack8(p0, 8), pa2 = pack8(p1, 0), pa3 = pack8(p1, 8);
#pragma unroll
    for (int d0 = 0; d0 < 2; ++d0) {
#pragma unroll
        for (int ks = 0; ks < 4; ++ks) {
            const s16x4 lo = vtr(vp + d0 * 4096 + ks * 1024), hh = vtr(vp + d0 * 4096 + ks * 1024 + 512);
            const bf16x8 vf = {lo[0], lo[1], lo[2], lo[3], hh[0], hh[1], hh[2], hh[3]};
            const bf16x8 pa = ks == 0 ? pa0 : (ks == 1 ? pa1 : (ks == 2 ? pa2 : pa3));
            o[d0] = __builtin_amdgcn_mfma_f32_32x32x16_bf16(pa, vf, o[d0], 0, 0, 0);
        }
    }
}
template <bool ACCUM> __device__ __forceinline__ void scale_rows(Ctx& c, f32x16* dst, const f32x16* src, float f) {
    LAS float* wsf = (LAS float*)(c.lds + LDS_WS) + c.wid * 64;
    if (c.hi == 0) wsf[c.r32] = f;
    asm volatile("s_waitcnt lgkmcnt(0)" ::: "memory");
#pragma unroll
    for (int r = 0; r < 16; ++r) { const float fr_ = wsf[crow(r, c.hi)];
        if (ACCUM) { dst[0][r] += src[0][r] * fr_; dst[1][r] += src[1][r] * fr_; } else { dst[0][r] = src[0][r] * fr_; dst[1][r] = src[1][r] * fr_; } }
    asm volatile("s_waitcnt lgkmcnt(0)" ::: "memory");
}

template <int EM> __device__ __forceinline__ void emit(Ctx& c, float f, bf16* ob) {
    LAS float* wsf = (LAS float*)(c.lds + LDS_WS) + c.wid * 64;
    LAS float* outb = (LAS float*)(c.lds + LDS_IMP) + c.wid * 2048 + c.lane;
    if (c.hi == 0) wsf[c.r32] = f;
    asm volatile("s_waitcnt lgkmcnt(0)" ::: "memory");
#pragma unroll
    for (int r = 0; r < 16; ++r) { const float fr_ = wsf[crow(r, c.hi)];
#pragma unroll
        for (int d0 = 0; d0 < 2; ++d0) { float v = c.o[d0][r] * fr_; const int idx = d0 * 16 + r;
            if (EM == 0) outb[idx * 64] = v;
            else if (EM == 1) outb[idx * 64] += v;
            else { v += outb[idx * 64]; ob[(size_t)crow(r, c.hi) * D + 32 * d0] = (bf16)(cvt_pk_bf16(v, 0.f) & 0xffffu); } } }
    asm volatile("s_waitcnt lgkmcnt(0)" ::: "memory");
}

template <int MODE> __device__ __forceinline__ void tile_step(Ctx& c, int slot, int klo, int khi, int ct) {
    f32x16 p0, p1;
    qkt(p0, p1, (lcp)(c.lds + LDS_K + slot * 8192), c.qr, c.r32, c.hi);
    const int lo_ = klo - 4 * c.hi, hi_ = khi - 4 * c.hi;
    float rm = NEGF;
#pragma unroll
    for (int r = 0; r < 16; ++r) { const int kk = (r & 3) + 8 * (r >> 2);
        const bool v0 = (kk >= lo_) && (kk <= hi_), v1 = (kk + 32 >= lo_) && (kk + 32 <= hi_);
        p0[r] = v0 ? p0[r] : NEGF; p1[r] = v1 ? p1[r] : NEGF;
        rm = fmaxf(rm, fmaxf(p0[r], p1[r])); }
    rm = xor32_max(rm);
    if (MODE == 1) {
        const float mf = c.m, il = c.inv_l;
#pragma unroll
        for (int r = 0; r < 16; ++r) { p0[r] = (p0[r] > 0.5f * NEGF) ? __builtin_amdgcn_exp2f(p0[r] - mf) * il : 0.f; p1[r] = (p1[r] > 0.5f * NEGF) ? __builtin_amdgcn_exp2f(p1[r] - mf) * il : 0.f; }
        LAS float* imp = (LAS float*)(c.lds + LDS_IMP) + (c.hp * 64 + c.tl) * 64 + 16 * ct + c.hi;
#pragma unroll
        for (int h2 = 0; h2 < 2; ++h2) {
            const f32x16& p = h2 ? p1 : p0;
            float Y[4];
#pragma unroll
            for (int k = 0; k < 4; ++k) Y[k] = xor32_other(p[4 * k + 3], c.hi);
#pragma unroll
            for (int k = 0; k < 4; ++k) {
                const float g4 = (p[4 * k] + p[4 * k + 1]) + (p[4 * k + 2] + p[4 * k + 3]);
                const float prev = c.hi ? Y[k] : (k == 0 ? c.carry : Y[k - 1]);
                imp[8 * h2 + 2 * k] = g4 + prev;
            }
            c.carry = Y[3];
        }
        pv(c.o, (lcp)(c.lds + LDS_V + slot * 8192) + ((c.lane >> 4) & 1) * 32 + (c.lane & 3) * 8 + (4 * c.hi + ((c.lane & 15) >> 2)) * 64, p0, p1);
    } else {
        const float mn = fmaxf(c.m, rm);
        const float alpha = __builtin_amdgcn_exp2f(c.m - mn);
        float s = 0.f;
#pragma unroll
        for (int r = 0; r < 16; ++r) { p0[r] = (p0[r] > 0.5f * NEGF) ? __builtin_amdgcn_exp2f(p0[r] - mn) : 0.f; p1[r] = (p1[r] > 0.5f * NEGF) ? __builtin_amdgcn_exp2f(p1[r] - mn) : 0.f; s += p0[r] + p1[r]; }
        c.l = c.l * alpha + s; c.m = mn;
        if (MODE >= 2) {
            if (__any(alpha != 1.0f)) scale_rows<false>(c, c.o, c.o, alpha);
            pv(c.o, (lcp)(c.lds + LDS_V + slot * 8192) + ((c.lane >> 4) & 1) * 32 + (c.lane & 3) * 8 + (4 * c.hi + ((c.lane & 15) >> 2)) * 64, p0, p1);
        }
    }
}

struct MaskP { int cmaxq; unsigned sel_lo, sel_hi; int cur; };
template <int MODE> __device__ __forceinline__ void tile_mask(const Ctx& c, const MaskP& mp, int tile, int& klo, int& khi) {
    if (MODE <= 1) { klo = 0; khi = mp.cmaxq - 64 * tile; }
    else if (MODE == 2) { const unsigned bit = tile < 32 ? (mp.sel_lo >> tile) & 1u : (mp.sel_hi >> (tile - 32)) & 1u;
        klo = bit ? 0 : 64; khi = (tile == mp.cur) ? c.tl : 63; }
    else { if (tile == mp.cur) { klo = 0; khi = c.tl; } else if (tile == mp.cur - 8) { klo = c.tl + 1; khi = 63; } else { klo = 0; khi = 63; } }
}
template <int MODE> __device__ __forceinline__ void run_branch(Ctx& c, const MaskP& mp, const bf16* kb, const bf16* vb, int pitch, int tile0, int ntiles) {
    u32x4 kr, vr;
    load_tile_regs(kb, vb, pitch, tile0, c.wid, c.lane, kr, vr);
    store_tile_lds(c.lds, 0, c.wid, c.lane, kr, vr);
    __syncthreads();
    for (int i = 0; i < ntiles; ++i) {
        const bool more = (i + 1 < ntiles);
        if (more) load_tile_regs(kb, vb, pitch, tile0 + i + 1, c.wid, c.lane, kr, vr);
        int klo, khi; tile_mask<MODE>(c, mp, tile0 + i, klo, khi);
        tile_step<MODE>(c, i & 1, klo, khi, tile0 + i);
        if (more) store_tile_lds(c.lds, (i + 1) & 1, c.wid, c.lane, kr, vr);
        __syncthreads();
    }
}

struct Tensors { const bf16* qb; const bf16* kvb; const bf16* kc; const bf16* vc; const float* gates; bf16* ob; };

__device__ __forceinline__ void unit(const Tensors& T, int b, int g, int qb, LAS char* lds, const int tid) {
    Ctx c; c.lds = lds; c.lane = tid & 63; c.wid = __builtin_amdgcn_readfirstlane(tid >> 6); c.r32 = c.lane & 31; c.hi = c.lane >> 5;
    c.hp = c.wid >> 1; const int qh = c.wid & 1; c.tl = 32 * qh + c.r32;
    const int head = 4 * g + c.hp, s = qb * 64, t = s + c.tl; const size_t rowg = (size_t)b * SEQ + t;
#pragma unroll
    for (int d0 = 0; d0 < 4; ++d0) c.qr[d0] = *(const bf16x8*)(T.qb + rowg * D + head * 64 + d0 * 16 + c.hi * 8);
    const float g0 = T.gates[rowg * 48 + head * 3 + 0], g1 = T.gates[rowg * 48 + head * 3 + 1], g2 = T.gates[rowg * 48 + head * 3 + 2];
    MaskP mp; mp.cur = qb; mp.cmaxq = (t >= 31) ? ((t - 31) >> 4) : -1; mp.sel_lo = 0u; mp.sel_hi = 0u;
    const int nct = ((4 * qb + 2) >> 6) + 1;
    const int bg = b * 4 + g;
    const bf16* kcb = T.kc + (size_t)bg * 256 * 64; const bf16* vcb = T.vc + (size_t)bg * 256 * 64;
    const bf16* kvrow = T.kvb + (size_t)b * SEQ * NKV + g * 64;
#pragma unroll
    for (int r = 0; r < 16; ++r) { c.o[0][r] = 0.f; c.o[1][r] = 0.f; }
    c.m = NEGF; c.l = 0.f; c.inv_l = 0.f; c.carry = 0.f;
    run_branch<0>(c, mp, kcb, vcb, 64, 0, nct);
    { const float lt = xor32_sum(c.l); c.inv_l = lt > 0.f ? 1.0f / lt : 0.f; }
    run_branch<1>(c, mp, kcb, vcb, 64, 0, nct);
    {
        LAS float* imp = (LAS float*)(lds + LDS_IMP); LAS float* tot = (LAS float*)(lds + LDS_TOT); LAS unsigned* selw = (LAS unsigned*)(lds + LDS_SEL);
        const int cur = qb;
        for (int idx = tid; idx < 4096; idx += 512) { const int n = idx & 63;
            float v = 0.f; if (n <= cur) v = ((imp[idx] + imp[4096 + idx]) + imp[8192 + idx]) + imp[12288 + idx];
            tot[idx] = v; }
        __syncthreads();
        const int q = tid >> 3, sub = tid & 7; const int nf = cur >= 2 ? 3 : cur + 1; const int Kn = 16 - nf;
        unsigned bits = 0u;
        for (int i = 0; i < 8; ++i) { const int n = sub * 8 + i; bool sb;
            if (n > cur) sb = false; else if (n == 0 || n >= cur - 1) sb = true;
            else { const float v = tot[q * 64 + n]; int rank = 0;
                for (int n2 = 1; n2 <= cur - 2; ++n2) { const float v2 = tot[q * 64 + n2]; rank += ((v2 > v) || (v2 == v && n2 < n)) ? 1 : 0; }
                sb = rank < Kn; }
            bits |= (sb ? 1u : 0u) << i; }
        unsigned lo32 = sub < 4 ? bits << (8 * sub) : 0u, hi32 = sub >= 4 ? bits << (8 * (sub - 4)) : 0u;
        lo32 |= swz_xor_u<1>(lo32); hi32 |= swz_xor_u<1>(hi32); lo32 |= swz_xor_u<2>(lo32); hi32 |= swz_xor_u<2>(hi32); lo32 |= swz_xor_u<4>(lo32); hi32 |= swz_xor_u<4>(hi32);
        if (sub == 0) { selw[q * 2] = lo32; selw[q * 2 + 1] = hi32; }
        __syncthreads();
        mp.sel_lo = selw[c.tl * 2]; mp.sel_hi = selw[c.tl * 2 + 1];
    }
    bf16* ob = T.ob + ((size_t)b * SEQ + s + 32 * qh) * D + head * 64 + c.r32;
    emit<0>(c, g0, ob);
#pragma unroll
    for (int r = 0; r < 16; ++r) { c.o[0][r] = 0.f; c.o[1][r] = 0.f; }
    c.m = NEGF; c.l = 0.f;
    run_branch<2>(c, mp, kvrow + 512, kvrow + 768, NKV, 0, qb + 1);
    { const float lt = xor32_sum(c.l); emit<1>(c, lt > 0.f ? g1 / lt : 0.f, ob); }
#pragma unroll
    for (int r = 0; r < 16; ++r) { c.o[0][r] = 0.f; c.o[1][r] = 0.f; }
    c.m = NEGF; c.l = 0.f;
    { const int w0 = qb >= 8 ? qb - 8 : 0; run_branch<3>(c, mp, kvrow + 1024, kvrow + 1280, NKV, w0, qb - w0 + 1); }
    { const float lt = xor32_sum(c.l); emit<2>(c, lt > 0.f ? g2 / lt : 0.f, ob); }
    __syncthreads();
}
}

constexpr size_t MiB = 1u << 20, KiB = 1u << 10;
constexpr size_t WS_CTL = 0, CTL_ZERO_BYTES = 1 * MiB;
constexpr size_t WS_SSQ0 = 1 * MiB, WS_SSQ1 = 1 * MiB + 512 * KiB;
constexpr size_t WS_ROPE = 2 * MiB;
constexpr size_t WS_ROPEC = 3 * MiB;
constexpr size_t WS_CB1 = 3 * MiB + 128 * KiB;
constexpr size_t WS_GATES = 4 * MiB;
constexpr size_t WS_KC = 7 * MiB, WS_VC = 7 * MiB + 512 * KiB;
constexpr size_t WS_HID = 8 * MiB;
constexpr size_t WS_WUP = 16 * MiB;
constexpr size_t WS_WDN = 60 * MiB;
constexpr size_t WS_WG = 82 * MiB;
constexpr size_t WS_WPP = 90 * MiB;
constexpr size_t WS_WPOOL = 92 * MiB;
constexpr size_t WS_WKVQ2 = 93 * MiB;
constexpr size_t WS_WQ3 = 99 * MiB;
constexpr size_t WS_WOUT = 102 * MiB;
constexpr size_t WS_WC1 = 106 * MiB;
constexpr size_t WS_PB = 108 * MiB;
constexpr size_t WS_PP = 140 * MiB;
constexpr size_t WS_XB = 173 * MiB;
constexpr size_t WS_KVB = 206 * MiB;
constexpr size_t WS_H = 255 * MiB;
constexpr size_t WS_QO = WS_H;
constexpr size_t WS_UPOOL = WS_H;
constexpr size_t WS_XBG = WS_H + 32 * MiB;
constexpr size_t WS_END = 343 * MiB;
constexpr int CW_BAR = 4096;

constexpr int RING_BYTES = 131072;
constexpr int LDSCTL_OFF = 139264, MISC_OFF = LDSCTL_OFF + 320;
constexpr int LDS_BYTES = LDSCTL_OFF + 1024;
constexpr int NWAVES = 8;

typedef GAS unsigned gu32;
#define RLX_AGENT __ATOMIC_RELAXED, __HIP_MEMORY_SCOPE_AGENT
#define LDS_WAIT() asm volatile("s_waitcnt lgkmcnt(0)" ::: "memory")
__device__ __forceinline__ unsigned f2bf(float f) { unsigned u = __builtin_bit_cast(unsigned, f); return (u + 0x7fffu + ((u >> 16) & 1u)) >> 16; }
__device__ __forceinline__ unsigned pk2(float lo, float hi) { return f2bf(lo) | (f2bf(hi) << 16); }
__device__ __forceinline__ float wave_sum(float v) {
    v += swz_xor<1>(v); v += swz_xor<2>(v); v += swz_xor<4>(v); v += swz_xor<8>(v); v += swz_xor<16>(v);
    return xor32_sum(v);
}

#define XB_TMO      128
#define XB_XCNT(j)  (256  + 64 * (j))
#define XB_XSUB(j)  (1280 + 64 * (j))
#define XB_XGEN(j)  (2304 + 64 * (j))
#define XB_TOP      3328
#define XB_TOPGEN   3392
#define XCD_BAR_WORDS 3456
#define XB_SPIN_CAP (1u << 18)

__device__ __forceinline__ unsigned xb_ld(unsigned* p)              { return __hip_atomic_load(p, __ATOMIC_RELAXED, __HIP_MEMORY_SCOPE_AGENT); }
__device__ __forceinline__ unsigned xb_add(unsigned* p, unsigned v) { return __hip_atomic_fetch_add(p, v, __ATOMIC_RELAXED, __HIP_MEMORY_SCOPE_AGENT); }
__device__ __forceinline__ unsigned xb_xcc_id() { return (unsigned)__builtin_amdgcn_s_getreg((3 << 11) | 20) & 0xFu; }
#define XB_SPIN(cond, bar) do { unsigned _sp = 0; while (cond) { __builtin_amdgcn_s_sleep(1); \
    if ((++_sp & 255u) == 0u) { if (xb_ld(&(bar)[XB_TMO])) break; if (_sp > XB_SPIN_CAP) { atomicAdd(&(bar)[XB_TMO], 1u); break; } } } } while (0)

struct XcdBarrier {
    unsigned* bar; unsigned x;
    volatile LAS unsigned* st;
};

__device__ __forceinline__ XcdBarrier xcd_barrier_post(unsigned* bar, volatile LAS unsigned* st) {
    XcdBarrier b; b.bar = bar; b.x = xb_xcc_id(); b.st = st;
    if (threadIdx.x == 0) (void)xb_add(&bar[XB_XCNT(b.x)], 1u);
    return b;
}
__device__ __forceinline__ void xcd_barrier_complete(unsigned* bar, unsigned x, unsigned& nloc, unsigned& nx) {
    const unsigned G = gridDim.x * gridDim.y * gridDim.z;
    unsigned sum, cnt, mine, sp = 0u;
    for (;;) {
        sum = 0u; cnt = 0u; mine = 0u;
#pragma unroll
        for (unsigned j = 0; j < 16; ++j) { const unsigned c = xb_ld(&bar[XB_XCNT(j)]); sum += c; cnt += (c > 0u) ? 1u : 0u; mine = (j == x) ? c : mine; }
        if (sum == G) break;
        __builtin_amdgcn_s_sleep(1);
        if ((++sp & 255u) == 0u) { if (xb_ld(&bar[XB_TMO])) break; if (sp > XB_SPIN_CAP) { atomicAdd(&bar[XB_TMO], 1u); break; } }
    }
    nloc = mine > 0u ? mine : 1u; nx = cnt > 0u ? cnt : 1u;
}

__device__ __forceinline__ void xcd_barrier(const XcdBarrier& b) {
    asm volatile("s_waitcnt vmcnt(0)" ::: "memory");
    __syncthreads();
    if (threadIdx.x == 0) {
        unsigned* bar = b.bar;
        __builtin_amdgcn_s_waitcnt(0);
        unsigned nloc = b.st[0], nx = b.st[1];
        if (nloc == 0u) { xcd_barrier_complete(bar, b.x, nloc, nx); b.st[0] = nloc; b.st[1] = nx; }
        const unsigned old = xb_add(&bar[XB_XSUB(b.x)], 1u);
        const unsigned gen = old / nloc;
        if (old + 1u == (gen + 1u) * nloc) {
            __builtin_amdgcn_fence(__ATOMIC_RELEASE, "agent");
            asm volatile("s_waitcnt vmcnt(0)" ::: "memory");
            const unsigned og = xb_add(&bar[XB_TOP], 1u);
            const unsigned tg = og / nx;
            if (og + 1u == (tg + 1u) * nx) xb_add(&bar[XB_TOPGEN], 1u);
            else XB_SPIN(xb_ld(&bar[XB_TOPGEN]) == tg, bar);
            __builtin_amdgcn_fence(__ATOMIC_ACQUIRE, "agent");
            xb_add(&bar[XB_XGEN(b.x)], 1u);
            asm volatile("s_waitcnt vmcnt(0)" ::: "memory");
        } else {
            XB_SPIN(xb_ld(&bar[XB_XGEN(b.x)]) == gen, bar);
            __builtin_amdgcn_fence(__ATOMIC_ACQUIRE, "agent");
            asm volatile("s_waitcnt vmcnt(0)" ::: "memory");
        }
    }
    __syncthreads();
}


struct Args { const void* in[25]; float* out; unsigned char* ws; int ph_lo, ph_hi; };

struct Frame {
    LAS unsigned char* lds;
    int tid, lane, wave, vcu, G;
    unsigned char* ws;
};

__device__ __forceinline__ void transpose_item(const float* W, int N, int k0, int n0, bf16* WT, int ldt, int dst_row0, const float* gk, const float* gn, LAS float* scr, int lane) {
    const int n = n0 + (lane & 31); const bool nv = n < N;
    const float sn = (gn && nv) ? gn[n] : 1.0f;
#pragma unroll 8
    for (int i = 0; i < 32; ++i) { const int kk = 2 * i + (lane >> 5);
        float v = nv ? W[(size_t)(k0 + kk) * N + n] : 0.f; if (gk) v *= gk[k0 + kk]; scr[kk * 33 + (lane & 31)] = v * sn; }
    LDS_WAIT(); asm volatile("" ::: "memory");
    const int c = lane & 7;
#pragma unroll
    for (int j = 0; j < 4; ++j) { const int nn = (lane >> 3) + 8 * j; const LAS float* s = scr + (8 * c) * 33 + nn;
        u32x4 o; o.x = pk2(s[0 * 33], s[1 * 33]); o.y = pk2(s[2 * 33], s[3 * 33]); o.z = pk2(s[4 * 33], s[5 * 33]); o.w = pk2(s[6 * 33], s[7 * 33]);
        *(u32x4*)(WT + (size_t)(dst_row0 + nn) * ldt + k0 + 8 * c) = o; }
    LDS_WAIT(); asm volatile("" ::: "memory");
}
__device__ __forceinline__ void sincos_f(float a, float& cs, float& sn) {
    const float q = rintf(a * 0.636619772f); float r = fmaf(-q, 1.5707963705062866f, a); r = fmaf(-q, -4.37113883e-8f, r);
    const float r2 = r * r;
    const float sp = r * (1.0f + r2 * (-1.666666667e-1f + r2 * (8.333333333e-3f + r2 * (-1.984126984e-4f + r2 * 2.755731922e-6f))));
    const float cp = 1.0f + r2 * (-0.5f + r2 * (4.166666667e-2f + r2 * (-1.388888889e-3f + r2 * 2.480158730e-5f)));
    const int qi = ((int)q) & 3;
    sn = (qi == 0) ? sp : (qi == 1) ? cp : (qi == 2) ? -sp : -cp;
    cs = (qi == 0) ? cp : (qi == 1) ? -sp : (qi == 2) ? -cp : sp;
}
__device__ __forceinline__ float inv_freq(int j) {
    return j == 0 ? 0x1.0p+0f : j == 1 ? 0x1.8d275ep-3f : j == 2 ? 0x1.341190p-5f : j == 3 ? 0x1.ddee9cp-8f : j == 4 ? 0x1.72ba44p-10f : j == 5 ? 0x1.1f91f0p-12f : j == 6 ? 0x1.be2188p-15f : 0x1.5a0f4ep-17f;
}

__device__ __forceinline__ void phase_prologue(Frame& F, const Args& a) {
    const float* x = (const float*)a.in[0]; const float* p = (const float*)a.in[1]; const int* pos = (const int*)a.in[2];
    const float* norm_mix = (const float*)a.in[3]; const float* pool_w = (const float*)a.in[4]; const float* pool_scale = (const float*)a.in[5];
    const float* norm_kv = (const float*)a.in[6]; const float* w_kv = (const float*)a.in[7];
    const float* cmp_pos_k = (const float*)a.in[8]; const float* cmp_pos_v = (const float*)a.in[11]; const float* cmp_w1_k = (const float*)a.in[9]; const float* cmp_w1_v = (const float*)a.in[12];
    const float* w_in = (const float*)a.in[14]; const float* w_out = (const float*)a.in[15];
    const float* norm_ffn = (const float*)a.in[16]; const float* ffn_up = (const float*)a.in[17]; const float* ffn_down = (const float*)a.in[20];
    const float* norm_ple = (const float*)a.in[21]; const float* ple_gate = (const float*)a.in[22]; const float* ple_proj = (const float*)a.in[23];
    unsigned char* ws = F.ws;
    LAS float* scr = (LAS float*)(F.lds + F.wave * 16384);
    const int gw = F.vcu * NWAVES + F.wave, NGW = F.G * NWAVES;
    const int gt = gw * 64 + F.lane, NGT = NGW * 64;
    constexpr int I_UP = 16 * 176, I_DN = 44 * 32, I_G = 16 * 32, I_PP = 4 * 32, I_POOL = 4 * 8, I_KV = 16 * 48, I_IN = 16 * 34, I_OUT = 16 * 32, I_C1 = 32 * 4;
    constexpr int T_UP = 4 * I_UP, T_DN = 4 * I_DN, T_G = 4 * I_G, T_PP = 4 * I_PP, T_POOL = 8 * I_POOL, T_KV = I_KV, T_IN = 2 * I_IN, T_OUT = 2 * I_OUT, T_C1 = 2 * I_C1;
    constexpr int NITEMS = T_UP + T_DN + T_G + T_PP + T_POOL + T_KV + T_IN + T_OUT + T_C1;
    for (int it = gw; it < NITEMS; it += NGW) {
        int r = it;
        if (r < T_UP) { const int l = r / I_UP, q = r % I_UP, kb = q / 176, nb = q % 176, n0 = 32 * nb;
            const int dst = (n0 < FF) ? (n0 / 128) * 256 + (n0 % 128) : ((n0 - FF) / 128) * 256 + 128 + ((n0 - FF) % 128);
            transpose_item(ffn_up + (size_t)l * D * FF2, FF2, 64 * kb, n0, (bf16*)(ws + WS_WUP) + (size_t)l * FF2 * D, D, dst, norm_ffn + l * D, nullptr, scr, F.lane); continue; } r -= T_UP;
        if (r < T_DN) { const int l = r / I_DN, q = r % I_DN, kb = q / 32, nb = q % 32;
            transpose_item(ffn_down + (size_t)l * FF * D, D, 64 * kb, 32 * nb, (bf16*)(ws + WS_WDN) + (size_t)l * D * FF, FF, 32 * nb, nullptr, nullptr, scr, F.lane); continue; } r -= T_DN;
        if (r < T_G) { const int l = r / I_G, q = r % I_G, kb = q / 32, nb = q % 32;
            transpose_item(ple_gate + (size_t)l * D * D, D, 64 * kb, 32 * nb, (bf16*)(ws + WS_WG) + (size_t)l * D * D, D, 32 * nb, norm_ple + l * D, nullptr, scr, F.lane); continue; } r -= T_G;
        if (r < T_PP) { const int l = r / I_PP, q = r % I_PP, kb = q / 32, nb = q % 32;
            transpose_item(ple_proj + (size_t)l * PLE * D, D, 64 * kb, 32 * nb, (bf16*)(ws + WS_WPP) + (size_t)l * D * PLE, PLE, 32 * nb, nullptr, nullptr, scr, F.lane); continue; } r -= T_PP;
        if (r < T_POOL) { const int lg = r / I_POOL, q = r % I_POOL, kb = q / 8, nb = q % 8, l = lg >> 2, gi = lg & 3;
            transpose_item(pool_w + (size_t)lg * 256 * 256, 256, 64 * kb, 32 * nb, (bf16*)(ws + WS_WPOOL) + (size_t)l * D * 256, 256, gi * 256 + 32 * nb, nullptr, pool_scale + l * D + gi * 256, scr, F.lane); continue; } r -= T_POOL;
        if (r < T_KV) { const int kb = r / 48, nb = r % 48;
            transpose_item(w_kv, NKV, 64 * kb, 32 * nb, (bf16*)(ws + WS_WKVQ2), D, 32 * nb, norm_kv, nullptr, scr, F.lane); continue; } r -= T_KV;
        if (r < T_IN) { const int j = r / I_IN, q = r % I_IN, kb = q / 34, nb = q % 34;
            bf16* dstp = j == 0 ? (bf16*)(ws + WS_WKVQ2) + (size_t)NKV * D : (bf16*)(ws + WS_WQ3);
            transpose_item(w_in + (size_t)j * D * NQC, NQC, 64 * kb, 32 * nb, dstp, D, 32 * nb, norm_mix + (2 + j) * D, nullptr, scr, F.lane); continue; } r -= T_IN;
        if (r < T_OUT) { const int j = r / I_OUT, q = r % I_OUT, kb = q / 32, nb = q % 32;
            transpose_item(w_out + (size_t)j * D * D, D, 64 * kb, 32 * nb, (bf16*)(ws + WS_WOUT) + (size_t)j * D * D, D, 32 * nb, nullptr, nullptr, scr, F.lane); continue; } r -= T_OUT;
        { const int wh = r / I_C1, q = r % I_C1, kb = q / 4, nb = q % 4;
            transpose_item(wh ? cmp_w1_v : cmp_w1_k, 128, 64 * kb, 32 * nb, (bf16*)(ws + WS_WC1) + (size_t)wh * 256 * 2048, 2048, 32 * nb, nullptr, nullptr, scr, F.lane); }
    }
    {
        constexpr int Z1 = 192 * D / 8, Z3 = 128 * 2048 / 8;
        for (int i = gt; i < 2 * Z1 + 2 * Z3; i += NGT) {
            u32x4* dst;
            if (i < Z1) dst = (u32x4*)((bf16*)(ws + WS_WKVQ2) + (size_t)2624 * D) + i;
            else if (i < 2 * Z1) dst = (u32x4*)((bf16*)(ws + WS_WQ3) + (size_t)1088 * D) + (i - Z1);
            else if (i < 2 * Z1 + Z3) dst = (u32x4*)((bf16*)(ws + WS_WC1) + (size_t)128 * 2048) + (i - 2 * Z1);
            else dst = (u32x4*)((bf16*)(ws + WS_WC1) + (size_t)256 * 2048 + (size_t)128 * 2048) + (i - 2 * Z1 - Z3);
            unsigned zz = 0u; asm volatile("" : "+v"(zz)); const u32x4 z = {zz, zz, zz, zz};
            *dst = z;
        }
    }
    { const f32x4* src = (const f32x4*)p; u32x4* dst = (u32x4*)(ws + WS_PB); const int n8 = DEPTH * M * PLE / 8;
      for (int i = gt; i < n8; i += NGT) { const f32x4 a0 = src[2 * i], a1 = src[2 * i + 1]; u32x4 o; o.x = pk2(a0[0], a0[1]); o.y = pk2(a0[2], a0[3]); o.z = pk2(a1[0], a1[1]); o.w = pk2(a1[2], a1[3]); dst[i] = o; } }
    { float* rope = (float*)(ws + WS_ROPE);
      for (int i = gt; i < M * 8; i += NGT) { const int row = i >> 3, j = i & 7; const float ang = (float)pos[row] * inv_freq(j); float cs, sn; sincos_f(ang, cs, sn); rope[row * 16 + j] = cs; rope[row * 16 + 8 + j] = sn; }
      float* ropec = (float*)(ws + WS_ROPEC);
      for (int i = gt; i < NBATCH * 256 * 8; i += NGT) { const int j = i & 7, c = (i >> 3) & 255, b = i >> 11; float cs = 1.f, sn = 0.f;
          if (c < 255) { const float ang = (float)pos[b * SEQ + 16 * c + 31] * inv_freq(j); sincos_f(ang, cs, sn); }
          ropec[(b * 256 + c) * 16 + j] = cs; ropec[(b * 256 + c) * 16 + 8 + j] = sn; } }
    { float* cb1 = (float*)(ws + WS_CB1);
      for (int o = gw; o < 256; o += NGW) { const int wh = o >> 7, j = o & 127; float s = 0.f;
          const float* cp_ = wh ? cmp_pos_v : cmp_pos_k; const float* cw_ = wh ? cmp_w1_v : cmp_w1_k;
          for (int k = F.lane; k < 2048; k += 64) s += cp_[k] * cw_[(size_t)k * 128 + j];
          s = wave_sum(s); if (F.lane == 0) cb1[o] = s; } }
    { float* ssq = (float*)(ws + WS_SSQ0);
      for (int m = gw; m < M; m += NGW) { const f32x4* xr = (const f32x4*)(x + (size_t)m * D) + F.lane; float s = 0.f;
#pragma unroll
          for (int j = 0; j < 4; ++j) { const f32x4 v = xr[64 * j]; s += (v[0] * v[0] + v[1] * v[1]) + (v[2] * v[2] + v[3] * v[3]); }
          s = wave_sum(s); if (F.lane == 0) { f32x4 o = {s, 0.f, 0.f, 0.f}; *(f32x4*)(ssq + (size_t)m * 4) = o; } } }
}

__device__ __forceinline__ void phase_poolprep(Frame& F, const float* xsrc, const float* ssq, const float* gmix, bf16* upool) {
    const int gw = F.vcu * NWAVES + F.wave, NGW = F.G * NWAVES;
    for (int task = gw; task < 4 * (M / 32); task += NGW) {
        const int j = task & 3, strip = task >> 2, t0 = strip * 32, bs = t0 & ~(SEQ - 1), W = 2 << j;
        const int col = 256 * j + 4 * F.lane;
        const f32x4 gv = *(const f32x4*)(gmix + col);
        f32x4 ring[16];
#pragma unroll
        for (int k = 0; k < 15; ++k) { const int tp = t0 - 15 + k; f32x4 hv = {0.f, 0.f, 0.f, 0.f};
            if (tp >= bs) { const float rs = row_rstd(ssq, tp); hv = *(const f32x4*)(xsrc + (size_t)tp * D + col) * rs * gv; }
            ring[(k + 1) & 15] = hv; }
#pragma unroll
        for (int i = 0; i < 32; ++i) { const int t = t0 + i; const float rs = row_rstd(ssq, t);
            const f32x4 hv = *(const f32x4*)(xsrc + (size_t)t * D + col) * rs * gv;
            ring[i & 15] = hv;
            f32x4 sum = hv;
#pragma unroll
            for (int k = 1; k < 16; ++k) if (k < W) sum += ring[(i - k) & 15];
            const int cnt = (t - bs + 1) < W ? (t - bs + 1) : W;
            const f32x4 u = sum * (1.0f / (float)cnt) - hv;
            u32x2 o; o.x = cvt_pk_bf16(u[0], u[1]); o.y = cvt_pk_bf16(u[2], u[3]);
            *(u32x2*)(upool + (size_t)t * D + col) = o; }
    }
}

__device__ __forceinline__ void phase_cmp2(Frame& F, const bf16* hid, const float* w2k, const float* w2v, const float* ropec, bf16* kc, bf16* vc) {
    const int gw = F.vcu * NWAVES + F.wave, NGW = F.G * NWAVES;
    for (int task = gw; task < 2 * 4096; task += NGW) {
        const int wh = task >> 12, row = task & 4095, c = row & 255, bg = row >> 8, b = bg >> 2, d = F.lane;
        const float* w2 = wh ? w2v : w2k; const bf16* hr = hid + ((size_t)wh * 4096 + row) * 128;
        float s = 0.f;
        for (int j = 0; j < 128; ++j) s += __uint_as_float(((unsigned)hr[j]) << 16) * w2[j * 64 + d];
        if (wh == 0) { const float partner = swz_xor<8>(s);
            if (d < 16) { const float cs = ropec[(b * 256 + c) * 16 + (d & 7)], sn = ropec[(b * 256 + c) * 16 + 8 + (d & 7)]; s = (d < 8) ? s * cs - partner * sn : s * cs + partner * sn; } }
        if (c == 255) s = 0.f;
        (wh ? vc : kc)[(size_t)row * 64 + d] = (bf16)f2bf(s);
    }
}

__device__ __forceinline__ void phase_final(Frame& F, float* x, const float* gfin) {
    const int gw = F.vcu * NWAVES + F.wave, NGW = F.G * NWAVES;
    for (int m = gw; m < M; m += NGW) { f32x4* xr = (f32x4*)(x + (size_t)m * D) + F.lane; f32x4 v[4]; float s = 0.f;
#pragma unroll
        for (int j = 0; j < 4; ++j) { v[j] = xr[64 * j]; s += (v[j][0] * v[j][0] + v[j][1] * v[j][1]) + (v[j][2] * v[j][2] + v[j][3] * v[j][3]); }
        const float rs = rsqrtf(wave_sum(s) * (1.0f / D) + EPS);
#pragma unroll
        for (int j = 0; j < 4; ++j) { const f32x4 gv = *((const f32x4*)gfin + F.lane + 64 * j); xr[64 * j] = v[j] * rs * gv; } }
}

enum PhaseKind { K_PRO = 0, K_PREP, K_POOLG, K_KVQ, K_CMP1, K_CMP2, K_ATT, K_WOUT, K_UP, K_DOWN, K_GATE, K_FINAL };
constexpr int NPHASES = 26;
#ifndef PH_MASK
#define PH_MASK 0xFFFF
#endif
#define PH_EN(k) (((PH_MASK) >> (k)) & 1)
__host__ __device__ __forceinline__ void decode_phase(int ph, int& kind, int& l) {
    if (ph == 0) { kind = K_PRO; l = 0; return; }
    if (ph >= 25) { kind = K_FINAL; l = 3; return; }
    int idx;
    if (ph < 6) { l = 0; idx = ph - 1; } else if (ph < 11) { l = 1; idx = ph - 6; } else if (ph < 19) { l = 2; idx = ph - 11; } else { l = 3; idx = ph - 19; }
    if (l < 2) { kind = idx == 0 ? K_PREP : idx == 1 ? K_POOLG : idx == 2 ? K_UP : idx == 3 ? K_DOWN : K_GATE; }
    else if (l == 2) { kind = idx == 0 ? K_KVQ : idx == 1 ? K_CMP1 : idx == 2 ? K_CMP2 : idx == 3 ? K_ATT : idx == 4 ? K_WOUT : idx == 5 ? K_UP : idx == 6 ? K_DOWN : K_GATE; }
    else { kind = idx == 0 ? K_KVQ : idx == 1 ? K_ATT : idx == 2 ? K_WOUT : idx == 3 ? K_UP : idx == 4 ? K_DOWN : K_GATE; }
}

struct CmpOrder {
    int c; const char* kvb; const char* wc1;
    __device__ __forceinline__ bool next(int i, pg8::Unit& u) const {
        if (i != 0 || c >= 32) return false;
        const int bg = c >> 1, which = c & 1, b = bg >> 2, g = bg & 3;
        u.pm = bg; u.pn = which; u.a = kvb + ((size_t)b * SEQ * NKV + which * 256 + g * 64) * 2; u.b = wc1 + (size_t)which * 256 * 2048 * 2; return true; }
    __device__ __forceinline__ void a_ready(const pg8::Unit&) const {}
    __device__ __forceinline__ void done(const pg8::Unit&) const {}
};

__global__ void __launch_bounds__(NWAVES * 64, 2) fwd_kernel(Args args) {
    extern __shared__ __attribute__((aligned(16))) unsigned char lds_raw[];
    LAS unsigned char* const lds0 = (LAS unsigned char*)lds_raw;
    volatile LAS unsigned* MISC = (volatile LAS unsigned*)(lds0 + MISC_OFF);
    const int wave_s = __builtin_amdgcn_readfirstlane((int)threadIdx.x >> 6);
    for (int u = threadIdx.x; u < (LDS_BYTES - LDSCTL_OFF) / 4; u += NWAVES * 64) ((LAS unsigned*)(lds0 + LDSCTL_OFF))[u] = 0u;
    __syncthreads();
    XcdBarrier bar; bar.bar = (unsigned*)((gu32*)(args.ws + WS_CTL) + CW_BAR); bar.x = 0; bar.st = nullptr;
    const int lo = args.ph_lo, hi = args.ph_hi;
    if (hi - lo > 1) bar = xcd_barrier_post((unsigned*)((gu32*)(args.ws + WS_CTL) + CW_BAR), MISC + 8);

    int ver = 0;
#define SSQ(v) ((float*)(ws + (((v) & 1) ? WS_SSQ1 : WS_SSQ0)))
    for (int ph = 0; ph < hi; ++ph) {
        int kind, l; decode_phase(ph, kind, l);
        const bool run = ph >= lo;
        if (run) {
            int bx_l = blockIdx.x; asm volatile("" : "+s"(bx_l));
            unsigned char* ws = args.ws; asm volatile("" : "+s"(ws));
            const int G_l = gridDim.x, vcu_l = (G_l % 8 == 0) ? (bx_l % 8) * (G_l / 8) + bx_l / 8 : bx_l;
#define FRESH_TID(name) int name; { int z_ = 0; asm volatile("" : "+v"(z_)); name = wave_s * 64 + (int)__builtin_amdgcn_mbcnt_hi(~0u, __builtin_amdgcn_mbcnt_lo(~0u, (unsigned)z_)); }
#define MAKE_FRAME(F, t) Frame F; F.lds = lds0; F.tid = (t); F.lane = (t) & 63; F.wave = wave_s; F.G = G_l; F.vcu = vcu_l; F.ws = ws;
            const float* x_in = (const float*)args.in[0]; float* X = args.out;
            bf16* XB = (bf16*)(ws + WS_XB); bf16* XBG = (bf16*)(ws + WS_XBG); bf16* PP = (bf16*)(ws + WS_PP); bf16* HB = (bf16*)(ws + WS_H);
            bf16* KVB = (bf16*)(ws + WS_KVB); bf16* QO = (bf16*)(ws + WS_QO); bf16* UPOOL = (bf16*)(ws + WS_UPOOL);
            const int cblk = bx_l;
            if (PH_EN(K_PRO) && kind == K_PRO) { FRESH_TID(t_) MAKE_FRAME(F, t_) phase_prologue(F, args); }
            if (PH_EN(K_PREP) && kind == K_PREP) { FRESH_TID(t_) MAKE_FRAME(F, t_) phase_poolprep(F, l == 0 ? x_in : (const float*)X, SSQ(ver), (const float*)args.in[3] + l * D, UPOOL); }
            if (PH_EN(K_POOLG) && (kind == K_POOLG || kind == K_KVQ)) {
                pg8::Gemm g{PLE, PLE, 128, 128, 4};
                pg8::GridOrder S{64, 4, G_l, cblk, (const char*)(ws + WS_PB) + (size_t)l * M * PLE * 2, (const char*)(ws + WS_WPP) + (size_t)l * D * PLE * 2, (size_t)256 * PLE * 2, 0, (size_t)256 * PLE * 2, 1 << 30, 0};
                EpiPP E{PP};
                { FRESH_TID(t_)
                pg8::gemm_phase<EpiPP, pg8::GridOrder, true, true>(lds0, g, S, E, t_); }
            }
            if (PH_EN(K_KVQ) && kind == K_KVQ) {
                const int nN = (l == 2) ? 11 : 5;
                pg8::Gemm g{D, D, 128, 128, 16};
                pg8::GridOrder S{64, nN, G_l, cblk, (const char*)XBG, (const char*)(ws + (l == 2 ? WS_WKVQ2 : WS_WQ3)), (size_t)256 * D * 2, 0, (size_t)256 * D * 2, 1 << 30, 0};
                EpiKVQ E{SSQ(ver), (const float*)(ws + WS_ROPE), KVB, QO, (float*)(ws + WS_GATES), (l == 2) ? 6 : 0};
                { FRESH_TID(t_)
                pg8::gemm_phase<EpiKVQ, pg8::GridOrder, true, true>(lds0, g, S, E, t_); }
            }
            if (PH_EN(K_CMP1) && kind == K_CMP1) {
                pg8::Gemm g{16 * NKV, 2048, NKV * 2, 128, 32};
                CmpOrder S{cblk, (const char*)KVB, (const char*)(ws + WS_WC1)};
                EpiCMP E{(const float*)(ws + WS_CB1), (bf16*)(ws + WS_HID)};
                { FRESH_TID(t_)
                pg8::gemm_phase<EpiCMP, CmpOrder, true, true>(lds0, g, S, E, t_); }
            }
            if (PH_EN(K_CMP2) && kind == K_CMP2) { FRESH_TID(t_) MAKE_FRAME(F, t_) phase_cmp2(F, (const bf16*)(ws + WS_HID), (const float*)args.in[10], (const float*)args.in[13], (const float*)(ws + WS_ROPEC), (bf16*)(ws + WS_KC), (bf16*)(ws + WS_VC)); }
            if (PH_EN(K_ATT) && kind == K_ATT) {
                att::Tensors T{QO, KVB, (const bf16*)(ws + WS_KC), (const bf16*)(ws + WS_VC), (const float*)(ws + WS_GATES), QO};
                const int bgi = (vcu_l >> 4) & 15, s = vcu_l & 15;
                for (int i = 0; i < 4; ++i) { const int qb = (i == 0) ? s : (i == 1) ? 31 - s : (i == 2) ? 32 + s : 63 - s;
                    FRESH_TID(t_) att::unit(T, bgi >> 2, bgi & 3, qb, (LAS char*)lds0, t_); }
            }
            if (PH_EN(K_DOWN) && (kind == K_POOLG || kind == K_WOUT || kind == K_DOWN)) {
                pg8::Gemm g; pg8::GridOrder S; S.nM = 64; S.nN = 4; S.G = G_l; S.c = cblk; S.pm_div = 1 << 30; S.b_pm = 0;
                const float* xold = X;
                if (kind == K_POOLG) { g = pg8::Gemm{D, 256, 128, 128, 4}; S.A = (const char*)UPOOL; S.a_tile = (size_t)256 * D * 2; S.a_pn = 512; S.B = (const char*)(ws + WS_WPOOL) + (size_t)l * D * 256 * 2; S.b_tile = (size_t)256 * 256 * 2; if (l == 0) xold = x_in; }
                else if (kind == K_WOUT) { g = pg8::Gemm{D, D, 128, 128, 16}; S.A = (const char*)QO; S.a_tile = (size_t)256 * D * 2; S.a_pn = 0; S.B = (const char*)(ws + WS_WOUT) + (size_t)(l - 2) * D * D * 2; S.b_tile = (size_t)256 * D * 2; }
                else { g = pg8::Gemm{FF, FF, 128, 128, 44}; S.A = (const char*)HB; S.a_tile = (size_t)256 * FF * 2; S.a_pn = 0; S.B = (const char*)(ws + WS_WDN) + (size_t)l * D * FF * 2; S.b_tile = (size_t)256 * FF * 2; }
                EpiX<0> E{xold, X, XB, SSQ(ver + 1), nullptr, nullptr};
                { FRESH_TID(t_)
                pg8::gemm_phase<EpiX<0>, pg8::GridOrder, false, true>(lds0, g, S, E, t_); }
            }
            if (PH_EN(K_UP) && kind == K_UP) {
                pg8::Gemm g{D, D, 128, 128, 16};
                EpiUP E{SSQ(ver), (const float*)args.in[18] + (size_t)l * 3 * FF2, (const float*)args.in[19] + (size_t)l * FF2, HB};
                for (int i = 0;; ++i) {
                    int pm, pn; if (!pg8::tile_order(NUPM, 22, G_l, cblk, i, pm, pn)) break;
                    pg8::OneUnit S; S.valid = true; S.u.pm = pm; S.u.pn = pn;
                    S.u.a = (const char*)XB + ((long)UPM * pm - 2) * (long)(D * 2); S.u.b = (const char*)(ws + WS_WUP) + ((size_t)l * FF2 + (size_t)pn * 256) * D * 2;
                    { FRESH_TID(t_)
                    pg8::gemm_phase<EpiUP, pg8::OneUnit, false, true>(lds0, g, S, E, t_); }
                }
            }
            if (PH_EN(K_GATE) && kind == K_GATE) {
                pg8::Gemm g{D, D, 128, 128, 16};
                pg8::GridOrder S{64, 4, G_l, cblk, (const char*)XB, (const char*)(ws + WS_WG) + (size_t)l * D * D * 2, (size_t)256 * D * 2, 0, (size_t)256 * D * 2, 1 << 30, 0};
                EpiX<1> E{X, X, XBG, SSQ(ver + 1), SSQ(ver), PP};
                { FRESH_TID(t_)
                pg8::gemm_phase<EpiX<1>, pg8::GridOrder, false, true>(lds0, g, S, E, t_); }
            }
            if (PH_EN(K_FINAL) && kind == K_FINAL) { FRESH_TID(t_) MAKE_FRAME(F, t_) phase_final(F, X, (const float*)args.in[24]); }
            if (ph + 1 < hi) { XcdBarrier b2 = bar; asm volatile("" : "+s"(b2.bar)); xcd_barrier(b2); }
        }
        if (kind == K_POOLG || kind == K_WOUT || kind == K_DOWN || kind == K_GATE) ++ver;
    }
}

extern "C" void kernel_launch(void* const* d_in, const int* in_sizes, int n_in, void* d_out, int out_size, void* d_ws, size_t ws_size, hipStream_t stream) {
    static int grid = 0;
    if (grid == 0) {
        if (n_in != 25 || out_size != M * D || ws_size < WS_END) { fprintf(stderr, "kernel_launch: unexpected shapes (n_in %d, out %d, ws %zu < %zu); nothing launched\n", n_in, out_size, ws_size, (size_t)WS_END); grid = -1; return; }
        int dev = 0, cus = 0, per_cu = 0;
        if (hipGetDevice(&dev) != hipSuccess || hipDeviceGetAttribute(&cus, hipDeviceAttributeMultiprocessorCount, dev) != hipSuccess) { grid = -1; return; }
        if (hipFuncSetAttribute((const void*)fwd_kernel, hipFuncAttributeMaxDynamicSharedMemorySize, LDS_BYTES) != hipSuccess) { fprintf(stderr, "kernel_launch: hipFuncSetAttribute failed\n"); grid = -1; return; }
        if (hipOccupancyMaxActiveBlocksPerMultiprocessor(&per_cu, (const void*)fwd_kernel, NWAVES * 64, LDS_BYTES) != hipSuccess || per_cu < 1) fprintf(stderr, "kernel_launch: occupancy query reports %d\n", per_cu);
        (void)hipGetLastError();
        grid = 256;
        if (cus != 256) fprintf(stderr, "kernel_launch: device has %d CUs, kernel is built for 256\n", cus);
    }
    if (grid < 0) return;
    if (hipMemsetAsync((char*)d_ws + WS_CTL, 0, CTL_ZERO_BYTES, stream) != hipSuccess) return;
    Args a{};
    for (int i = 0; i < 25; ++i) a.in[i] = d_in[i];
    a.out = (float*)d_out; a.ws = (unsigned char*)d_ws;
#if MK_PER_PHASE
    for (int ph = 0; ph < NPHASES; ++ph) { a.ph_lo = ph; a.ph_hi = ph + 1; hipLaunchKernelGGL(fwd_kernel, dim3(grid), dim3(NWAVES * 64), LDS_BYTES, stream, a); }
#else
    a.ph_lo = 0; a.ph_hi = NPHASES;
    hipLaunchKernelGGL(fwd_kernel, dim3(grid), dim3(NWAVES * 64), LDS_BYTES, stream, a);
#endif
}
```

```cpp
#include <hip/hip_runtime.h>
#include <hip/hip_bf16.h>
#include <cstdio>
#include <cstdint>
#include <cmath>

#ifndef MK_PER_PHASE
#define MK_PER_PHASE 0
#endif

namespace pg8 {
#define PG8_LAS __attribute__((address_space(3)))
typedef unsigned short bf16_t;
typedef short bf16x8 __attribute__((ext_vector_type(8)));
typedef float f32x4 __attribute__((ext_vector_type(4)));
typedef unsigned u32x4 __attribute__((ext_vector_type(4)));
typedef unsigned u32x2 __attribute__((ext_vector_type(2)));
constexpr int BM = 256, BK = 64, HALF = 128, HTB = HALF * BK * 2, STAGE_BYTES = 8 * HTB, NXCD = 8, WGM = 8;

__host__ __device__ __forceinline__ int lds_byte(int r, int c) { const int st = (r >> 4) * 2 + (c >> 5), rr = r & 15, cc = c & 31, ob = rr * 64 + cc * 2; return st * 1024 + (ob ^ (((ob >> 9) & 1) << 5)); }
__host__ __device__ __forceinline__ void stage_rc(int b, int& R, int& C) { const int st = b / 1024, sb = b % 1024, swz = sb ^ (((sb >> 9) & 1) << 5); R = (st >> 1) * 16 + swz / 64; C = (st & 1) * 32 + (swz % 64) / 2; }
__host__ __device__ __forceinline__ int perm32(int rho) { const int n = rho >> 4, i = rho & 15; return 8 * (i >> 2) + 4 * n + (i & 3); }

struct Unit { int pm, pn; const char* a; const char* b; };
struct Gemm { int lda, ldb; int kstepA, kstepB; int nt; };

__device__ __forceinline__ bool tile_order(int nM, int nN, int G, int c, int i, int& pm, int& pn) {
    const int nwg = nM * nN; const long L = (long)i * G + c; if (L >= nwg) return false;
    int wgid = (int)L; { const int q = nwg / NXCD, r = nwg % NXCD, xcd = wgid % NXCD, off = wgid / NXCD; wgid = (xcd < r ? xcd * (q + 1) : r * (q + 1) + (xcd - r) * q) + off; }
    const int nig = WGM * nN, gid = wgid / nig, fm = gid * WGM, gsz = (nM - fm) < WGM ? (nM - fm) : WGM;
    pm = fm + ((wgid % nig) % gsz); pn = (wgid % nig) / gsz; return true;
}
struct GridOrder {
    int nM, nN, G, c; const char* A; const char* B; size_t a_tile, a_pn, b_tile; int pm_div; size_t b_pm;
    __device__ __forceinline__ bool next(int i, Unit& u) const {
        int pm, pn; if (!tile_order(nM, nN, G, c, i, pm, pn)) return false;
        u.pm = pm; u.pn = pn; u.a = A + (size_t)pm * a_tile + (size_t)pn * a_pn; u.b = B + (size_t)pn * b_tile + (size_t)(pm / pm_div) * b_pm; return true; }
    __device__ __forceinline__ void a_ready(const Unit&) const {}
    __device__ __forceinline__ void done(const Unit&) const {}
};
struct OneUnit { Unit u; bool valid;
    __device__ __forceinline__ bool next(int i, Unit& o) const { if (i != 0 || !valid) return false; o = u; return true; }
    __device__ __forceinline__ void a_ready(const Unit&) const {}
    __device__ __forceinline__ void done(const Unit&) const {}
};
__device__ __forceinline__ unsigned cvt_pk_bf16(float lo, float hi) { unsigned r; asm volatile("v_cvt_pk_bf16_f32 %0, %1, %2" : "=v"(r) : "v"(lo), "v"(hi)); return r; }
__device__ __forceinline__ float bf_lo(unsigned w) { return __uint_as_float(w << 16); }
__device__ __forceinline__ float bf_hi(unsigned w) { return __uint_as_float(w & 0xffff0000u); }
__device__ __forceinline__ float sigmoidf_(float v) { return 1.0f / (1.0f + __expf(-v)); }

template <class Epi, class Sched, bool ALIGN_EPI = false, bool SP2 = false>
__device__ __forceinline__ void gemm_phase(PG8_LAS unsigned char* lds, const Gemm g, const Sched& S, const Epi& E, const int tid) {
    const int wid = __builtin_amdgcn_readfirstlane(tid >> 6), lane = tid & 63, wr = wid >> 2, wc = wid & 3, fr = lane & 15, fq = lane >> 4;
    const int nt = g.nt;
    unsigned voffA[2], voffB[2];
#pragma unroll
    for (int i = 0; i < 2; ++i) { int R, C; stage_rc(tid * 16 + i * 8192, R, C); const int Rb = Epi::PERM ? ((R & ~31) + perm32(R & 31)) : R;
        voffA[i] = (unsigned)(R * g.lda + C) * 2u; voffB[i] = (unsigned)(Rb * g.ldb + C) * 2u; }
    const unsigned kstepA = (unsigned)g.kstepA, kstepB = (unsigned)g.kstepB;
    const unsigned hstepA = (unsigned)(HALF * g.lda * 2), hstepB = (unsigned)(HALF * g.ldb * 2);
    const unsigned ldsw = (unsigned)wid * 1024u;
    const int aoff = lds_byte(wr * 64 + fr, fq * 8), boff = lds_byte(wc * 32 + fr, fq * 8);
#define PG8_SA(b, h) (((b) * 2 + (h)) * HTB)
#define PG8_SB(b, h) ((4 + (b) * 2 + (h)) * HTB)
#define PG8_STAGE(bufoff, gbase, voff) do { _Pragma("unroll") for (int _i = 0; _i < 2; ++_i) \
        __builtin_amdgcn_global_load_lds((const unsigned*)((const char*)(gbase) + (voff)[_i]), (PG8_LAS unsigned*)(lds + (bufoff) + ldsw + _i * 8192), 16, 0, 0); } while (0)
#define PG8_LDA(dst, b, h) do { _Pragma("unroll") for (int m = 0; m < 4; ++m) _Pragma("unroll") for (int k = 0; k < 2; ++k) dst[m][k] = *(const PG8_LAS bf16x8*)(lds + PG8_SA(b, h) + aoff + m * 2048 + k * 1024); } while (0)
#define PG8_LDB(dst, b, h) do { _Pragma("unroll") for (int n = 0; n < 2; ++n) _Pragma("unroll") for (int k = 0; k < 2; ++k) dst[n][k] = *(const PG8_LAS bf16x8*)(lds + PG8_SB(b, h) + boff + n * 2048 + k * 1024); } while (0)
#define PG8_MMA(ai, bj, At, Bt) do { __builtin_amdgcn_s_setprio(1); _Pragma("unroll") for (int m = 0; m < 4; ++m) _Pragma("unroll") for (int n = 0; n < 2; ++n) _Pragma("unroll") for (int k = 0; k < 2; ++k) \
        acc[ai][bj][m][n] = __builtin_amdgcn_mfma_f32_16x16x32_bf16(Bt[n][k], At[m][k], acc[ai][bj][m][n], 0, 0, 0); __builtin_amdgcn_s_setprio(0); } while (0)
#define PG8_WAIT_V(n) asm volatile("s_waitcnt vmcnt(" #n ")" ::: "memory")
#define PG8_WAIT_L(n) asm volatile("s_waitcnt lgkmcnt(" #n ")" ::: "memory")
#define PG8_BAR __builtin_amdgcn_s_barrier()
#define PG8_SCHED __builtin_amdgcn_sched_barrier(0)
    Unit cur, nxt; int ui = 0;
    if (!S.next(0, cur)) return;
    f32x4 acc[2][2][4][2];
#pragma unroll
    for (int a = 0; a < 2; ++a)
#pragma unroll
        for (int b = 0; b < 2; ++b)
#pragma unroll
            for (int m = 0; m < 4; ++m)
#pragma unroll
                for (int n = 0; n < 2; ++n) acc[a][b][m][n] = (f32x4){0.f, 0.f, 0.f, 0.f};
    bf16x8 At[4][2], B0[2][2], B1[2][2];
    const char* cA = cur.a; const char* cB = cur.b;
    S.a_ready(cur);
    if constexpr (SP2) {
        PG8_STAGE(PG8_SB(0, 0), cB, voffB); PG8_STAGE(PG8_SB(0, 1), cB + hstepB, voffB); PG8_STAGE(PG8_SA(0, 0), cA, voffA); PG8_STAGE(PG8_SA(0, 1), cA + hstepA, voffA);
        if (wr == 1) PG8_BAR;
        PG8_WAIT_V(2); PG8_BAR;
        PG8_STAGE(PG8_SB(1, 0), cB + kstepB, voffB); PG8_STAGE(PG8_SA(1, 0), cA + kstepA, voffA); PG8_STAGE(PG8_SB(1, 1), cB + hstepB + kstepB, voffB);
        PG8_WAIT_V(6); PG8_BAR;
    } else {
        PG8_STAGE(PG8_SB(0, 0), cB, voffB); PG8_STAGE(PG8_SA(0, 0), cA, voffA); PG8_STAGE(PG8_SB(0, 1), cB + hstepB, voffB); PG8_STAGE(PG8_SA(0, 1), cA + hstepA, voffA);
        if (wr == 1) PG8_BAR;
        PG8_WAIT_V(4); PG8_BAR;
        PG8_STAGE(PG8_SB(1, 0), cB + kstepB, voffB); PG8_STAGE(PG8_SA(1, 0), cA + kstepA, voffA); PG8_STAGE(PG8_SB(1, 1), cB + hstepB + kstepB, voffB);
        PG8_WAIT_V(6); PG8_BAR;
    }
    for (;;) {
        const bool has_next = S.next(ui + 1, nxt);
        const char* nA = has_next ? nxt.a : cA; const char* nB = has_next ? nxt.b : cB;
        for (int t = 0; t < nt; t += 2) {
            const bool last = (t == nt - 2);
            const char* a1 = cA + (size_t)((unsigned)(t + 1) * kstepA);
            const char* a2 = last ? nA : cA + (size_t)((unsigned)(t + 2) * kstepA); const char* b2 = last ? nB : cB + (size_t)((unsigned)(t + 2) * kstepB);
            const char* a3 = a2 + kstepA; const char* b3 = b2 + kstepB;
            if (last && has_next) S.a_ready(nxt);
            if constexpr (SP2) {
            PG8_LDB(B0, 0, 0); PG8_LDB(B1, 0, 1); PG8_SCHED; PG8_LDA(At, 0, 0); PG8_STAGE(PG8_SA(1, 1), a1 + hstepA, voffA);
            PG8_WAIT_V(8); PG8_WAIT_L(0); PG8_BAR; PG8_MMA(0, 0, At, B0); PG8_MMA(0, 1, At, B1); PG8_BAR; PG8_SCHED;
            PG8_LDA(At, 0, 1); PG8_STAGE(PG8_SB(0, 0), b2, voffB); PG8_STAGE(PG8_SB(0, 1), b2 + hstepB, voffB); PG8_STAGE(PG8_SA(0, 0), a2, voffA);
            PG8_WAIT_V(8); PG8_WAIT_L(0); PG8_BAR; PG8_MMA(1, 0, At, B0); PG8_MMA(1, 1, At, B1); PG8_BAR; PG8_SCHED;
            PG8_LDB(B0, 1, 0); PG8_LDB(B1, 1, 1); PG8_SCHED; PG8_LDA(At, 1, 0); PG8_STAGE(PG8_SA(0, 1), a2 + hstepA, voffA);
            PG8_WAIT_V(8); PG8_WAIT_L(0); PG8_BAR; PG8_MMA(0, 0, At, B0); PG8_MMA(0, 1, At, B1); PG8_BAR; PG8_SCHED;
            PG8_LDA(At, 1, 1); PG8_STAGE(PG8_SB(1, 0), b3, voffB); PG8_STAGE(PG8_SB(1, 1), b3 + hstepB, voffB); PG8_STAGE(PG8_SA(1, 0), a3, voffA);
            PG8_WAIT_V(8); PG8_WAIT_L(0); PG8_BAR; PG8_MMA(1, 0, At, B0); PG8_MMA(1, 1, At, B1); PG8_BAR; PG8_SCHED;
            } else {
            PG8_LDB(B0, 0, 0); PG8_SCHED; PG8_LDA(At, 0, 0); PG8_STAGE(PG8_SA(1, 1), a1 + hstepA, voffA);
            PG8_WAIT_L(8); PG8_BAR; PG8_WAIT_L(0); PG8_MMA(0, 0, At, B0); PG8_BAR; PG8_SCHED;
            PG8_LDB(B1, 0, 1); PG8_STAGE(PG8_SB(0, 0), b2, voffB);
            PG8_BAR; PG8_WAIT_L(0); PG8_MMA(0, 1, At, B1); PG8_BAR;
            PG8_LDA(At, 0, 1); PG8_STAGE(PG8_SA(0, 0), a2, voffA);
            PG8_BAR; PG8_WAIT_L(0); PG8_MMA(1, 0, At, B0); PG8_BAR; PG8_SCHED;
            PG8_STAGE(PG8_SB(0, 1), b2 + hstepB, voffB);
            PG8_WAIT_V(6); PG8_BAR; PG8_MMA(1, 1, At, B1); PG8_BAR;
            PG8_LDB(B0, 1, 0); PG8_SCHED; PG8_LDA(At, 1, 0); PG8_STAGE(PG8_SA(0, 1), a2 + hstepA, voffA);
            PG8_WAIT_L(8); PG8_BAR; PG8_WAIT_L(0); PG8_MMA(0, 0, At, B0); PG8_BAR; PG8_SCHED;
            PG8_LDB(B1, 1, 1); PG8_STAGE(PG8_SB(1, 0), b3, voffB);
            PG8_BAR; PG8_WAIT_L(0); PG8_MMA(0, 1, At, B1); PG8_BAR;
            PG8_LDA(At, 1, 1); PG8_STAGE(PG8_SA(1, 0), a3, voffA);
            PG8_BAR; PG8_WAIT_L(0); PG8_MMA(1, 0, At, B0); PG8_BAR; PG8_SCHED;
            PG8_STAGE(PG8_SB(1, 1), b3 + hstepB, voffB);
            PG8_WAIT_V(6); PG8_BAR; PG8_MMA(1, 1, At, B1); PG8_BAR;
            }
        }
        if constexpr (ALIGN_EPI) { if (wr == 0) PG8_BAR; }
        if constexpr (!Epi::AFTER_DRAIN) { int z_e = 0; asm volatile("" : "+v"(z_e)); const int lane_e = (int)__builtin_amdgcn_mbcnt_hi(~0u, __builtin_amdgcn_mbcnt_lo(~0u, (unsigned)z_e)); const int fr_e = lane_e & 15, fq_e = lane_e >> 4; E(acc, cur, wr, wc, fr_e, fq_e); S.done(cur); }
        if (!has_next) break;
#pragma unroll
        for (int a = 0; a < 2; ++a)
#pragma unroll
            for (int b = 0; b < 2; ++b)
#pragma unroll
                for (int m = 0; m < 4; ++m)
#pragma unroll
                    for (int n = 0; n < 2; ++n) acc[a][b][m][n] = (f32x4){0.f, 0.f, 0.f, 0.f};
        cur = nxt; cA = nA; cB = nB; ++ui;
        if constexpr (ALIGN_EPI) { if (wr == 1) PG8_BAR; }
    }
    PG8_WAIT_V(0);
    if constexpr (!ALIGN_EPI) { if (wr == 0) PG8_BAR; }
    PG8_BAR;
    if constexpr (Epi::AFTER_DRAIN) { int z_e = 0; asm volatile("" : "+v"(z_e)); const int lane_e = (int)__builtin_amdgcn_mbcnt_hi(~0u, __builtin_amdgcn_mbcnt_lo(~0u, (unsigned)z_e)); const int fr_e = lane_e & 15, fq_e = lane_e >> 4; E.fused(acc, cur, wr, wc, fr_e, fq_e, lds, wid, lane_e); S.done(cur); }
#undef PG8_SA
#undef PG8_SB
#undef PG8_STAGE
#undef PG8_LDA
#undef PG8_LDB
#undef PG8_MMA
#undef PG8_WAIT_V
#undef PG8_WAIT_L
#undef PG8_BAR
#undef PG8_SCHED
}

}

constexpr int M = 16384, D = 1024, SEQ = 4096, NBATCH = 4, DEPTH = 4, FF = 2816, FF2 = 5632, PLE = 256;
constexpr int NKV = 1536, NQC = 1072;
constexpr float EPS = 1e-6f;
constexpr float QSCALE = 0.125f * 1.4426950408889634f;
constexpr int UPM = 254;
constexpr int NUPM = (M + UPM - 1) / UPM;
constexpr int TPITCH = 264;

#define GAS __attribute__((address_space(1)))
#define LAS __attribute__((address_space(3)))
typedef unsigned short bf16;
typedef float f32x4 __attribute__((ext_vector_type(4)));
typedef float f32x16 __attribute__((ext_vector_type(16)));
typedef short bf16x8 __attribute__((ext_vector_type(8)));
typedef short s16x4 __attribute__((ext_vector_type(4)));
typedef unsigned u32x4 __attribute__((ext_vector_type(4)));
typedef unsigned u32x2 __attribute__((ext_vector_type(2)));
using pg8::cvt_pk_bf16; using pg8::bf_lo; using pg8::bf_hi; using pg8::sigmoidf_;


template <int MASK> __device__ __forceinline__ float swz_xor(float v) { return __uint_as_float((unsigned)__builtin_amdgcn_ds_swizzle((int)__float_as_uint(v), 0x1F | (MASK << 10))); }
template <int MASK> __device__ __forceinline__ unsigned swz_xor_u(unsigned v) { return (unsigned)__builtin_amdgcn_ds_swizzle((int)v, 0x1F | (MASK << 10)); }
__device__ __forceinline__ float xor32_sum(float v) { auto rr = __builtin_amdgcn_permlane32_swap(__float_as_uint(v), __float_as_uint(v), false, false); return __uint_as_float(rr[0]) + __uint_as_float(rr[1]); }
__device__ __forceinline__ float xor32_max(float v) { auto rr = __builtin_amdgcn_permlane32_swap(__float_as_uint(v), __float_as_uint(v), false, false); return fmaxf(__uint_as_float(rr[0]), __uint_as_float(rr[1])); }
__device__ __forceinline__ float xor32_other(float v, int hi) { auto rr = __builtin_amdgcn_permlane32_swap(__float_as_uint(v), __float_as_uint(v), false, false); return __uint_as_float(hi ? rr[0] : rr[1]); }

__device__ __forceinline__ float row_rstd(const float* ssq, int row) {
    const f32x4 s = *(const f32x4*)(ssq + 4 * (size_t)row);
    return rsqrtf(((s[0] + s[1]) + (s[2] + s[3])) * (1.0f / 1024.0f) + EPS);
}
#define WG_BAR() do { asm volatile("s_waitcnt vmcnt(0) lgkmcnt(0)" ::: "memory"); __builtin_amdgcn_s_barrier(); asm volatile("" ::: "memory"); } while (0)

template <int MODE> struct EpiX {
    static constexpr bool PERM = false, AFTER_DRAIN = true;
    const float* xold; float* xnew; bf16* xb; float* ssq_out; const float* ssq_in; const bf16* pp;
    __device__ __forceinline__ void fused(pg8::f32x4 (&acc)[2][2][4][2], const pg8::Unit& u, int wr, int wc, int fr, int fq, PG8_LAS unsigned char* lds, int wid, int lane) const {
        LAS float* P = (LAS float*)lds;
        const int col0 = u.pn * 256 + wc * 32 + 4 * fq;
#pragma unroll
        for (int ai = 0; ai < 2; ++ai)
#pragma unroll
            for (int m = 0; m < 4; ++m) {
                const int r = ai * 128 + wr * 64 + m * 16 + fr, grow = u.pm * 256 + r; const size_t off = (size_t)grow * D + col0;
                float rs = 0.f; if (MODE == 1) rs = row_rstd(ssq_in, grow);
                float sq = 0.f;
#pragma unroll
                for (int bj = 0; bj < 2; ++bj)
#pragma unroll
                    for (int n = 0; n < 2; ++n) {
                        const size_t c = off + bj * 128 + n * 16;
                        f32x4 v = acc[ai][bj][m][n];
                        if (MODE == 1) { const u32x2 w = *(const u32x2*)(pp + c);
                            v[0] = sigmoidf_(rs * v[0]) * bf_lo(w.x); v[1] = sigmoidf_(rs * v[1]) * bf_hi(w.x); v[2] = sigmoidf_(rs * v[2]) * bf_lo(w.y); v[3] = sigmoidf_(rs * v[3]) * bf_hi(w.y); }
                        const f32x4 xo = *(const f32x4*)(xold + c); const f32x4 xn = xo + v;
                        *(f32x4*)(xnew + c) = xn;
                        u32x2 o; o.x = cvt_pk_bf16(xn[0], xn[1]); o.y = cvt_pk_bf16(xn[2], xn[3]); *(u32x2*)(xb + c) = o;
                        sq += (xn[0] * xn[0] + xn[1] * xn[1]) + (xn[2] * xn[2] + xn[3] * xn[3]);
                    }
                sq += swz_xor<16>(sq); sq = xor32_sum(sq);
                if (fq == 0) P[r * 4 + wc] = sq;
            }
        WG_BAR();
        const int tid = wid * 64 + lane;
        if (tid < 256) { const float s = (P[tid * 4 + 0] + P[tid * 4 + 1]) + (P[tid * 4 + 2] + P[tid * 4 + 3]); ssq_out[(size_t)(u.pm * 256 + tid) * 4 + u.pn] = s; }
        WG_BAR();
    }
};

struct EpiPP {
    static constexpr bool PERM = true, AFTER_DRAIN = false;
    bf16* O;
    __device__ __forceinline__ void operator()(const pg8::f32x4 (&acc)[2][2][4][2], const pg8::Unit& u, int wr, int wc, int fr, int fq) const {
        const int row0 = u.pm * 256 + wr * 64 + fr, col0 = u.pn * 256 + wc * 32 + 8 * fq;
#pragma unroll
        for (int ai = 0; ai < 2; ++ai)
#pragma unroll
            for (int m = 0; m < 4; ++m) { bf16* rowp = O + (size_t)(row0 + ai * 128 + m * 16) * D + col0;
#pragma unroll
                for (int bj = 0; bj < 2; ++bj) { const f32x4 v0 = acc[ai][bj][m][0], v1 = acc[ai][bj][m][1];
                    u32x4 w; w.x = cvt_pk_bf16(v0[0], v0[1]); w.y = cvt_pk_bf16(v0[2], v0[3]); w.z = cvt_pk_bf16(v1[0], v1[1]); w.w = cvt_pk_bf16(v1[2], v1[3]);
                    *(u32x4*)(rowp + bj * 128) = w; } }
    }
};

struct EpiKVQ {
    static constexpr bool PERM = true, AFTER_DRAIN = false;
    const float* ssq_in; const float* rope;
    bf16* kvb; bf16* qb; float* gates; int n_kv;
    __device__ __forceinline__ void operator()(const pg8::f32x4 (&acc)[2][2][4][2], const pg8::Unit& u, int wr, int wc, int fr, int fq) const {
        const int pn = u.pn; const int kind = pn < n_kv ? 0 : (pn < n_kv + 4 ? 1 : 2);
        const bool roped = (kind == 1) || (kind == 0 && (pn == 2 || pn == 4));
        const bool rope_wave = roped && ((wc & 1) == 0);
        const float sgn = (fq == 0) ? -1.f : 1.f;
#pragma unroll
        for (int ai = 0; ai < 2; ++ai)
#pragma unroll
            for (int m = 0; m < 4; ++m) {
                const int grow = u.pm * 256 + ai * 128 + wr * 64 + m * 16 + fr;
                const float rs = row_rstd(ssq_in, grow);
                f32x4 cs0 = {1.f, 1.f, 1.f, 1.f}, cs1 = cs0, sn0 = {0.f, 0.f, 0.f, 0.f}, sn1 = sn0;
                if (rope_wave && fq < 2) { const f32x4* rp = (const f32x4*)(rope + (size_t)grow * 16); cs0 = rp[0]; cs1 = rp[1]; sn0 = rp[2]; sn1 = rp[3]; }
#pragma unroll
                for (int bj = 0; bj < 2; ++bj) {
                    f32x4 v0 = acc[ai][bj][m][0] * rs, v1 = acc[ai][bj][m][1] * rs;
                    if (rope_wave) {
                        f32x4 p0, p1;
#pragma unroll
                        for (int e = 0; e < 4; ++e) { p0[e] = swz_xor<16>(v0[e]); p1[e] = swz_xor<16>(v1[e]); }
                        if (fq < 2) { v0 = v0 * cs0 + (p0 * sn0) * sgn; v1 = v1 * cs1 + (p1 * sn1) * sgn; }
                    }
                    const int cl = bj * 128 + wc * 32 + 8 * fq;
                    if (kind == 2) {
                        if (cl < 48) { float* g = gates + (size_t)grow * 48 + cl;
                            f32x4 a, b;
#pragma unroll
                            for (int e = 0; e < 4; ++e) { a[e] = sigmoidf_(v0[e]); b[e] = sigmoidf_(v1[e]); }
                            *(f32x4*)g = a; *(f32x4*)(g + 4) = b; }
                    } else {
                        if (kind == 1) { v0 = v0 * QSCALE; v1 = v1 * QSCALE; }
                        u32x4 w; w.x = cvt_pk_bf16(v0[0], v0[1]); w.y = cvt_pk_bf16(v0[2], v0[3]); w.z = cvt_pk_bf16(v1[0], v1[1]); w.w = cvt_pk_bf16(v1[2], v1[3]);
                        bf16* dst = (kind == 0) ? kvb + (size_t)grow * NKV + pn * 256 + cl : qb + (size_t)grow * D + (pn - n_kv) * 256 + cl;
                        *(u32x4*)dst = w;
                    }
                }
            }
    }
};

struct EpiCMP {
    static constexpr bool PERM = true, AFTER_DRAIN = false;
    const float* bias1;
    bf16* hid;
    __device__ __forceinline__ void operator()(const pg8::f32x4 (&acc)[2][2][4][2], const pg8::Unit& u, int wr, int wc, int fr, int fq) const {
        const int which = u.pn; const int cl = wc * 32 + 8 * fq;
        const f32x4 b0 = *(const f32x4*)(bias1 + which * 128 + cl), b1 = *(const f32x4*)(bias1 + which * 128 + cl + 4);
#pragma unroll
        for (int ai = 0; ai < 2; ++ai)
#pragma unroll
            for (int m = 0; m < 4; ++m) {
                const int row = u.pm * 256 + ai * 128 + wr * 64 + m * 16 + fr;
                f32x4 v0 = acc[ai][0][m][0] + b0, v1 = acc[ai][0][m][1] + b1;
#pragma unroll
                for (int e = 0; e < 4; ++e) {
                    { const float x = v0[e]; const float y = 0.7978845608028654f * (x + 0.044715f * x * x * x); v0[e] = x / (1.0f + __expf(-2.0f * y)); }
                    { const float x = v1[e]; const float y = 0.7978845608028654f * (x + 0.044715f * x * x * x); v1[e] = x / (1.0f + __expf(-2.0f * y)); }
                }
                u32x4 w; w.x = cvt_pk_bf16(v0[0], v0[1]); w.y = cvt_pk_bf16(v0[2], v0[3]); w.z = cvt_pk_bf16(v1[0], v1[1]); w.w = cvt_pk_bf16(v1[2], v1[3]);
                *(u32x4*)(hid + ((size_t)which * 4096 + row) * 128 + cl) = w;
            }
    }
};

struct EpiUP {
    static constexpr bool PERM = true, AFTER_DRAIN = true;
    const float* ssq_in; const float* convw; const float* convb;
    bf16* h;
    __device__ __forceinline__ void fused(pg8::f32x4 (&acc)[2][2][4][2], const pg8::Unit& u, int wr, int wc, int fr, int fq, PG8_LAS unsigned char* lds, int wid, int lane) const {
        LAS bf16* T = (LAS bf16*)lds;
        const int rbase = UPM * u.pm - 2;
#pragma unroll
        for (int ai = 0; ai < 2; ++ai)
#pragma unroll
            for (int m = 0; m < 4; ++m) {
                const int rl = ai * 128 + wr * 64 + m * 16 + fr; int grow = rbase + rl; grow = grow < 0 ? 0 : (grow >= M ? M - 1 : grow);
                const float rs = row_rstd(ssq_in, grow);
#pragma unroll
                for (int bj = 0; bj < 2; ++bj) { const f32x4 v0 = acc[ai][bj][m][0] * rs, v1 = acc[ai][bj][m][1] * rs;
                    u32x4 w; w.x = cvt_pk_bf16(v0[0], v0[1]); w.y = cvt_pk_bf16(v0[2], v0[3]); w.z = cvt_pk_bf16(v1[0], v1[1]); w.w = cvt_pk_bf16(v1[2], v1[3]);
                    *(LAS u32x4*)(T + rl * TPITCH + bj * 128 + wc * 32 + 8 * fq) = w; }
            }
        WG_BAR();
        const int tid = wid * 64 + lane, c8 = tid & 15, rsub = tid >> 4;
        const int hc = u.pn * 128 + c8 * 8;
        float wa[3][8], wg[3][8], ba[8], bg[8];
#pragma unroll
        for (int t = 0; t < 3; ++t) {
            const f32x4 a0 = *(const f32x4*)(convw + t * FF2 + hc), a1 = *(const f32x4*)(convw + t * FF2 + hc + 4);
            const f32x4 g0 = *(const f32x4*)(convw + t * FF2 + FF + hc), g1 = *(const f32x4*)(convw + t * FF2 + FF + hc + 4);
#pragma unroll
            for (int e = 0; e < 4; ++e) { wa[t][e] = a0[e]; wa[t][4 + e] = a1[e]; wg[t][e] = g0[e]; wg[t][4 + e] = g1[e]; }
        }
        { const f32x4 a0 = *(const f32x4*)(convb + hc), a1 = *(const f32x4*)(convb + hc + 4), g0 = *(const f32x4*)(convb + FF + hc), g1 = *(const f32x4*)(convb + FF + hc + 4);
#pragma unroll
          for (int e = 0; e < 4; ++e) { ba[e] = a0[e]; ba[4 + e] = a1[e]; bg[e] = g0[e]; bg[4 + e] = g1[e]; } }
        for (int p = 0; p < 8; ++p) {
            const int rl = p * 32 + rsub; const int grow = rbase + rl;
            if (rl >= 2 && grow < M) {
                const int t = grow & (SEQ - 1);
                const u32x4 z = {0u, 0u, 0u, 0u};
                const u32x4 a2 = *(const LAS u32x4*)(T + rl * TPITCH + c8 * 8), g2 = *(const LAS u32x4*)(T + rl * TPITCH + 128 + c8 * 8);
                u32x4 a1 = *(const LAS u32x4*)(T + (rl - 1) * TPITCH + c8 * 8), g1 = *(const LAS u32x4*)(T + (rl - 1) * TPITCH + 128 + c8 * 8);
                u32x4 a0 = *(const LAS u32x4*)(T + (rl - 2) * TPITCH + c8 * 8), g0 = *(const LAS u32x4*)(T + (rl - 2) * TPITCH + 128 + c8 * 8);
                if (t < 1) { a1 = z; g1 = z; }
                if (t < 2) { a0 = z; g0 = z; }
                float o[8];
#pragma unroll
                for (int e = 0; e < 4; ++e) {
                    const unsigned A0 = a0[e], A1 = a1[e], A2 = a2[e], G0 = g0[e], G1 = g1[e], G2 = g2[e];
                    const float al = ba[2 * e] + wa[0][2 * e] * bf_lo(A0) + wa[1][2 * e] * bf_lo(A1) + wa[2][2 * e] * bf_lo(A2);
                    const float ah = ba[2 * e + 1] + wa[0][2 * e + 1] * bf_hi(A0) + wa[1][2 * e + 1] * bf_hi(A1) + wa[2][2 * e + 1] * bf_hi(A2);
                    const float gl = bg[2 * e] + wg[0][2 * e] * bf_lo(G0) + wg[1][2 * e] * bf_lo(G1) + wg[2][2 * e] * bf_lo(G2);
                    const float gh = bg[2 * e + 1] + wg[0][2 * e + 1] * bf_hi(G0) + wg[1][2 * e + 1] * bf_hi(G1) + wg[2][2 * e + 1] * bf_hi(G2);
                    o[2 * e] = gl * sigmoidf_(gl) * al; o[2 * e + 1] = gh * sigmoidf_(gh) * ah;
                }
                u32x4 w; w.x = cvt_pk_bf16(o[0], o[1]); w.y = cvt_pk_bf16(o[2], o[3]); w.z = cvt_pk_bf16(o[4], o[5]); w.w = cvt_pk_bf16(o[6], o[7]);
                *(u32x4*)(h + (size_t)grow * FF + hc) = w;
            }
        }
        WG_BAR();
    }
};

namespace att {
constexpr int LDS_K = 0, LDS_V = 16384, LDS_WS = 32768, LDS_IMP = 40960, LDS_TOT = 106496, LDS_SEL = 122880;
constexpr float NEGF = -1e30f;
typedef const LAS char* lcp;
typedef short v4i16_t __attribute__((ext_vector_type(4)));
__device__ __forceinline__ s16x4 vtr(lcp p) { return __builtin_bit_cast(s16x4, __builtin_amdgcn_ds_read_tr16_b64_v4i16((LAS v4i16_t*)p)); }
__device__ __forceinline__ int crow(int r, int hi) { return (r & 3) + 8 * (r >> 2) + 4 * hi; }

struct Ctx {
    LAS char* lds; int wid, lane, r32, hi, tl;
    bf16x8 qr[4];
    float m, l; f32x16 o[2];
    float inv_l, carry; int hp;
};

__device__ __forceinline__ void load_tile_regs(const bf16* kb, const bf16* vb, int pitch, int tile, int wid, int lane, u32x4& kr, u32x4& vr) {
    kr = *(const u32x4*)(kb + (size_t)(tile * 64 + lane) * pitch + wid * 8);
    vr = *(const u32x4*)(vb + (size_t)(tile * 64 + 16 * (wid & 3) + (lane >> 2)) * pitch + (wid >> 2) * 32 + (lane & 3) * 8);
}
__device__ __forceinline__ void store_tile_lds(LAS char* lds, int slot, int wid, int lane, const u32x4& kr, const u32x4& vr) {
    *(LAS u32x4*)(lds + LDS_K + slot * 8192 + wid * 1024 + lane * 16) = kr;
    *(LAS u32x4*)(lds + LDS_V + slot * 8192 + wid * 1024 + lane * 16) = vr;
}
__device__ __forceinline__ void qkt(f32x16& p0, f32x16& p1, lcp kslot, const bf16x8* qr, int r32, int hi) {
    lcp kb = kslot + hi * 1024 + r32 * 16;
    f32x16 z;
#pragma unroll
    for (int r = 0; r < 16; ++r) z[r] = 0.f;
    p0 = z; p1 = z;
#pragma unroll
    for (int d0 = 0; d0 < 4; ++d0) {
        const bf16x8 b0 = *(const LAS bf16x8*)(kb + d0 * 2048);
        const bf16x8 b1 = *(const LAS bf16x8*)(kb + d0 * 2048 + 512);
        p0 = __builtin_amdgcn_mfma_f32_32x32x16_bf16(b0, qr[d0], p0, 0, 0, 0);
        p1 = __builtin_amdgcn_mfma_f32_32x32x16_bf16(b1, qr[d0], p1, 0, 0, 0);
    }
}
__device__ __forceinline__ bf16x8 pack8(const f32x16& p, int b) {
    u32x4 w; w.x = cvt_pk_bf16(p[b], p[b + 1]); w.y = cvt_pk_bf16(p[b + 2], p[b + 3]); w.z = cvt_pk_bf16(p[b + 4], p[b + 5]); w.w = cvt_pk_bf16(p[b + 6], p[b + 7]);
    return __builtin_bit_cast(bf16x8, w);
}
__device__ __forceinline__ void pv(f32x16* o, lcp vp, const f32x16& p0, const f32x16& p1) {
    const bf16x8 pa0 = pack8(p0, 0), pa1 = pack8(p0, 8), pa2 = pack8(p1, 0), pa3 = pack8(p1, 8);
#pragma unroll
    for (int d0 = 0; d0 < 2; ++d0) {
#pragma unroll
        for (int ks = 0; ks < 4; ++ks) {
            const s16x4 lo = vtr(vp + d0 * 4096 + ks * 1024), hh = vtr(vp + d0 * 4096 + ks * 1024 + 512);
            const bf16x8 vf = {lo[0], lo[1], lo[2], lo[3], hh[0], hh[1], hh[2], hh[3]};
            const bf16x8 pa = ks == 0 ? pa0 : (ks == 1 ? pa1 : (ks == 2 ? pa2 : pa3));
            o[d0] = __builtin_amdgcn_mfma_f32_32x32x16_bf16(pa, vf, o[d0], 0, 0, 0);
        }
    }
}
template <bool ACCUM> __device__ __forceinline__ void scale_rows(Ctx& c, f32x16* dst, const f32x16* src, float f) {
    LAS float* wsf = (LAS float*)(c.lds + LDS_WS) + c.wid * 64;
    if (c.hi == 0) wsf[c.r32] = f;
    asm volatile("s_waitcnt lgkmcnt(0)" ::: "memory");
#pragma unroll
    for (int r = 0; r < 16; ++r) { const float fr_ = wsf[crow(r, c.hi)];
        if (ACCUM) { dst[0][r] += src[0][r] * fr_; dst[1][r] += src[1][r] * fr_; } else { dst[0][r] = src[0][r] * fr_; dst[1][r] = src[1][r] * fr_; } }
    asm volatile("s_waitcnt lgkmcnt(0)" ::: "memory");
}

template <int EM> __device__ __forceinline__ void emit(Ctx& c, float f, bf16* ob) {
    LAS float* wsf = (LAS float*)(c.lds + LDS_WS) + c.wid * 64;
    LAS float* outb = (LAS float*)(c.lds + LDS_IMP) + c.wid * 2048 + c.lane;
    if (c.hi == 0) wsf[c.r32] = f;
    asm volatile("s_waitcnt lgkmcnt(0)" ::: "memory");
#pragma unroll
    for (int r = 0; r < 16; ++r) { const float fr_ = wsf[crow(r, c.hi)];
#pragma unroll
        for (int d0 = 0; d0 < 2; ++d0) { float v = c.o[d0][r] * fr_; const int idx = d0 * 16 + r;
            if (EM == 0) outb[idx * 64] = v;
            else if (EM == 1) outb[idx * 64] += v;
            else { v += outb[idx * 64]; ob[(size_t)crow(r, c.hi) * D + 32 * d0] = (bf16)(cvt_pk_bf16(v, 0.f) & 0xffffu); } } }
    asm volatile("s_waitcnt lgkmcnt(0)" ::: "memory");
}

template <int MODE> __device__ __forceinline__ void tile_step(Ctx& c, int slot, int klo, int khi, int ct) {
    f32x16 p0, p1;
    qkt(p0, p1, (lcp)(c.lds + LDS_K + slot * 8192), c.qr, c.r32, c.hi);
    const int lo_ = klo - 4 * c.hi, hi_ = khi - 4 * c.hi;
    float rm = NEGF;
#pragma unroll
    for (int r = 0; r < 16; ++r) { const int kk = (r & 3) + 8 * (r >> 2);
        const bool v0 = (kk >= lo_) && (kk <= hi_), v1 = (kk + 32 >= lo_) && (kk + 32 <= hi_);
        p0[r] = v0 ? p0[r] : NEGF; p1[r] = v1 ? p1[r] : NEGF;
        rm = fmaxf(rm, fmaxf(p0[r], p1[r])); }
    rm = xor32_max(rm);
    if (MODE == 1) {
        const float mf = c.m, il = c.inv_l;
#pragma unroll
        for (int r = 0; r < 16; ++r) { p0[r] = (p0[r] > 0.5f * NEGF) ? __builtin_amdgcn_exp2f(p0[r] - mf) * il : 0.f; p1[r] = (p1[r] > 0.5f * NEGF) ? __builtin_amdgcn_exp2f(p1[r] - mf) * il : 0.f; }
        LAS float* imp = (LAS float*)(c.lds + LDS_IMP) + (c.hp * 64 + c.tl) * 64 + 16 * ct + c.hi;
#pragma unroll
        for (int h2 = 0; h2 < 2; ++h2) {
            const f32x16& p = h2 ? p1 : p0;
            float Y[4];
#pragma unroll
            for (int k = 0; k < 4; ++k) Y[k] = xor32_other(p[4 * k + 3], c.hi);
#pragma unroll
            for (int k = 0; k < 4; ++k) {
                const float g4 = (p[4 * k] + p[4 * k + 1]) + (p[4 * k + 2] + p[4 * k + 3]);
                const float prev = c.hi ? Y[k] : (k == 0 ? c.carry : Y[k - 1]);
                imp[8 * h2 + 2 * k] = g4 + prev;
            }
            c.carry = Y[3];
        }
        pv(c.o, (lcp)(c.lds + LDS_V + slot * 8192) + ((c.lane >> 4) & 1) * 32 + (c.lane & 3) * 8 + (4 * c.hi + ((c.lane & 15) >> 2)) * 64, p0, p1);
    } else {
        const float mn = fmaxf(c.m, rm);
        const float alpha = __builtin_amdgcn_exp2f(c.m - mn);
        float s = 0.f;
#pragma unroll
        for (int r = 0; r < 16; ++r) { p0[r] = (p0[r] > 0.5f * NEGF) ? __builtin_amdgcn_exp2f(p0[r] - mn) : 0.f; p1[r] = (p1[r] > 0.5f * NEGF) ? __builtin_amdgcn_exp2f(p1[r] - mn) : 0.f; s += p0[r] + p1[r]; }
        c.l = c.l * alpha + s; c.m = mn;
        if (MODE >= 2) {
            if (__any(alpha != 1.0f)) scale_rows<false>(c, c.o, c.o, alpha);
            pv(c.o, (lcp)(c.lds + LDS_V + slot * 8192) + ((c.lane >> 4) & 1) * 32 + (c.lane & 3) * 8 + (4 * c.hi + ((c.lane & 15) >> 2)) * 64, p0, p1);
        }
    }
}

struct MaskP { int cmaxq; unsigned sel_lo, sel_hi; int cur; };
template <int MODE> __device__ __forceinline__ void tile_mask(const Ctx& c, const MaskP& mp, int tile, int& klo, int& khi) {
    if (MODE <= 1) { klo = 0; khi = mp.cmaxq - 64 * tile; }
    else if (MODE == 2) { const unsigned bit = tile < 32 ? (mp.sel_lo >> tile) & 1u : (mp.sel_hi >> (tile - 32)) & 1u;
        klo = bit ? 0 : 64; khi = (tile == mp.cur) ? c.tl : 63; }
    else { if (tile == mp.cur) { klo = 0; khi = c.tl; } else if (tile == mp.cur - 8) { klo = c.tl + 1; khi = 63; } else { klo = 0; khi = 63; } }
}
template <int MODE> __device__ __forceinline__ void run_branch(Ctx& c, const MaskP& mp, const bf16* kb, const bf16* vb, int pitch, int tile0, int ntiles) {
    u32x4 kr, vr;
    load_tile_regs(kb, vb, pitch, tile0, c.wid, c.lane, kr, vr);
    store_tile_lds(c.lds, 0, c.wid, c.lane, kr, vr);
    __syncthreads();
    for (int i = 0; i < ntiles; ++i) {
        const bool more = (i + 1 < ntiles);
        if (more) load_tile_regs(kb, vb, pitch, tile0 + i + 1, c.wid, c.lane, kr, vr);
        int klo, khi; tile_mask<MODE>(c, mp, tile0 + i, klo, khi);
        tile_step<MODE>(c, i & 1, klo, khi, tile0 + i);
        if (more) store_tile_lds(c.lds, (i + 1) & 1, c.wid, c.lane, kr, vr);
        __syncthreads();
    }
}

struct Tensors { const bf16* qb; const bf16* kvb; const bf16* kc; const bf16* vc; const float* gates; bf16* ob; };

__device__ __forceinline__ void unit(const Tensors& T, int b, int g, int qb, LAS char* lds, const int tid) {
    Ctx c; c.lds = lds; c.lane = tid & 63; c.wid = __builtin_amdgcn_readfirstlane(tid >> 6); c.r32 = c.lane & 31; c.hi = c.lane >> 5;
    c.hp = c.wid >> 1; const int qh = c.wid & 1; c.tl = 32 * qh + c.r32;
    const int head = 4 * g + c.hp, s = qb * 64, t = s + c.tl; const size_t rowg = (size_t)b * SEQ + t;
#pragma unroll
    for (int d0 = 0; d0 < 4; ++d0) c.qr[d0] = *(const bf16x8*)(T.qb + rowg * D + head * 64 + d0 * 16 + c.hi * 8);
    const float g0 = T.gates[rowg * 48 + head * 3 + 0], g1 = T.gates[rowg * 48 + head * 3 + 1], g2 = T.gates[rowg * 48 + head * 3 + 2];
    MaskP mp; mp.cur = qb; mp.cmaxq = (t >= 31) ? ((t - 31) >> 4) : -1; mp.sel_lo = 0u; mp.sel_hi = 0u;
    const int nct = ((4 * qb + 2) >> 6) + 1;
    const int bg = b * 4 + g;
    const bf16* kcb = T.kc + (size_t)bg * 256 * 64; const bf16* vcb = T.vc + (size_t)bg * 256 * 64;
    const bf16* kvrow = T.kvb + (size_t)b * SEQ * NKV + g * 64;
#pragma unroll
    for (int r = 0; r < 16; ++r) { c.o[0][r] = 0.f; c.o[1][r] = 0.f; }
    c.m = NEGF; c.l = 0.f; c.inv_l = 0.f; c.carry = 0.f;
    run_branch<0>(c, mp, kcb, vcb, 64, 0, nct);
    { const float lt = xor32_sum(c.l); c.inv_l = lt > 0.f ? 1.0f / lt : 0.f; }
    run_branch<1>(c, mp, kcb, vcb, 64, 0, nct);
    {
        LAS float* imp = (LAS float*)(lds + LDS_IMP); LAS float* tot = (LAS float*)(lds + LDS_TOT); LAS unsigned* selw = (LAS unsigned*)(lds + LDS_SEL);
        const int cur = qb;
        for (int idx = tid; idx < 4096; idx += 512) { const int n = idx & 63;
            float v = 0.f; if (n <= cur) v = ((imp[idx] + imp[4096 + idx]) + imp[8192 + idx]) + imp[12288 + idx];
            tot[idx] = v; }
        __syncthreads();
        const int q = tid >> 3, sub = tid & 7; const int nf = cur >= 2 ? 3 : cur + 1; const int Kn = 16 - nf;
        unsigned bits = 0u;
        for (int i = 0; i < 8; ++i) { const int n = sub * 8 + i; bool sb;
            if (n > cur) sb = false; else if (n == 0 || n >= cur - 1) sb = true;
            else { const float v = tot[q * 64 + n]; int rank = 0;
                for (int n2 = 1; n2 <= cur - 2; ++n2) { const float v2 = tot[q * 64 + n2]; rank += ((v2 > v) || (v2 == v && n2 < n)) ? 1 : 0; }
                sb = rank < Kn; }
            bits |= (sb ? 1u : 0u) << i; }
        unsigned lo32 = sub < 4 ? bits << (8 * sub) : 0u, hi32 = sub >= 4 ? bits << (8 * (sub - 4)) : 0u;
        lo32 |= swz_xor_u<1>(lo32); hi32 |= swz_xor_u<1>(hi32); lo32 |= swz_xor_u<2>(lo32); hi32 |= swz_xor_u<2>(hi32); lo32 |= swz_xor_u<4>(lo32); hi32 |= swz_xor_u<4>(hi32);
        if (sub == 0) { selw[q * 2] = lo32; selw[q * 2 + 1] = hi32; }
        __syncthreads();
        mp.sel_lo = selw[c.tl * 2]; mp.sel_hi = selw[c.tl * 2 + 1];
    }
    bf16* ob = T.ob + ((size_t)b * SEQ + s + 32 * qh) * D + head * 64 + c.r32;
    emit<0>(c, g0, ob);
#pragma unroll
    for (int r = 0; r < 16; ++r) { c.o[0][r] = 0.f; c.o[1][r] = 0.f; }
    c.m = NEGF; c.l = 0.f;
    run_branch<2>(c, mp, kvrow + 512, kvrow + 768, NKV, 0, qb + 1);
    { const float lt = xor32_sum(c.l); emit<1>(c, lt > 0.f ? g1 / lt : 0.f, ob); }
#pragma unroll
    for (int r = 0; r < 16; ++r) { c.o[0][r] = 0.f; c.o[1][r] = 0.f; }
    c.m = NEGF; c.l = 0.f;
    { const int w0 = qb >= 8 ? qb - 8 : 0; run_branch<3>(c, mp, kvrow + 1024, kvrow + 1280, NKV, w0, qb - w0 + 1); }
    { const float lt = xor32_sum(c.l); emit<2>(c, lt > 0.f ? g2 / lt : 0.f, ob); }
    __syncthreads();
}
}

constexpr size_t MiB = 1u << 20, KiB = 1u << 10;
constexpr size_t WS_CTL = 0, CTL_ZERO_BYTES = 1 * MiB;
constexpr size_t WS_SSQ0 = 1 * MiB, WS_SSQ1 = 1 * MiB + 512 * KiB;
constexpr size_t WS_ROPE = 2 * MiB;
constexpr size_t WS_ROPEC = 3 * MiB;
constexpr size_t WS_CB1 = 3 * MiB + 128 * KiB;
constexpr size_t WS_GATES = 4 * MiB;
constexpr size_t WS_KC = 7 * MiB, WS_VC = 7 * MiB + 512 * KiB;
constexpr size_t WS_HID = 8 * MiB;
constexpr size_t WS_WUP = 16 * MiB;
constexpr size_t WS_WDN = 60 * MiB;
constexpr size_t WS_WG = 82 * MiB;
constexpr size_t WS_WPP = 90 * MiB;
constexpr size_t WS_WPOOL = 92 * MiB;
constexpr size_t WS_WKVQ2 = 93 * MiB;
constexpr size_t WS_WQ3 = 99 * MiB;
constexpr size_t WS_WOUT = 102 * MiB;
constexpr size_t WS_WC1 = 106 * MiB;
constexpr size_t WS_PB = 108 * MiB;
constexpr size_t WS_PP = 140 * MiB;
constexpr size_t WS_XB = 173 * MiB;
constexpr size_t WS_KVB = 206 * MiB;
constexpr size_t WS_H = 255 * MiB;
constexpr size_t WS_QO = WS_H;
constexpr size_t WS_UPOOL = WS_H;
constexpr size_t WS_XBG = WS_H + 32 * MiB;
constexpr size_t WS_END = 343 * MiB;
constexpr int CW_BAR = 4096;

constexpr int RING_BYTES = 131072;
constexpr int LDSCTL_OFF = 139264, MISC_OFF = LDSCTL_OFF + 320;
constexpr int LDS_BYTES = LDSCTL_OFF + 1024;
constexpr int NWAVES = 8;

typedef GAS unsigned gu32;
#define RLX_AGENT __ATOMIC_RELAXED, __HIP_MEMORY_SCOPE_AGENT
#define LDS_WAIT() asm volatile("s_waitcnt lgkmcnt(0)" ::: "memory")
__device__ __forceinline__ unsigned f2bf(float f) { unsigned u = __builtin_bit_cast(unsigned, f); return (u + 0x7fffu + ((u >> 16) & 1u)) >> 16; }
__device__ __forceinline__ unsigned pk2(float lo, float hi) { return f2bf(lo) | (f2bf(hi) << 16); }
__device__ __forceinline__ float wave_sum(float v) {
    v += swz_xor<1>(v); v += swz_xor<2>(v); v += swz_xor<4>(v); v += swz_xor<8>(v); v += swz_xor<16>(v);
    return xor32_sum(v);
}

#define XB_TMO      128
#define XB_XCNT(j)  (256  + 64 * (j))
#define XB_XSUB(j)  (1280 + 64 * (j))
#define XB_XGEN(j)  (2304 + 64 * (j))
#define XB_TOP      3328
#define XB_TOPGEN   3392
#define XCD_BAR_WORDS 3456
#define XB_SPIN_CAP (1u << 18)

__device__ __forceinline__ unsigned xb_ld(unsigned* p)              { return __hip_atomic_load(p, __ATOMIC_RELAXED, __HIP_MEMORY_SCOPE_AGENT); }
__device__ __forceinline__ unsigned xb_add(unsigned* p, unsigned v) { return __hip_atomic_fetch_add(p, v, __ATOMIC_RELAXED, __HIP_MEMORY_SCOPE_AGENT); }
__device__ __forceinline__ unsigned xb_xcc_id() { return (unsigned)__builtin_amdgcn_s_getreg((3 << 11) | 20) & 0xFu; }
#define XB_SPIN(cond, bar) do { unsigned _sp = 0; while (cond) { __builtin_amdgcn_s_sleep(1); \
    if ((++_sp & 255u) == 0u) { if (xb_ld(&(bar)[XB_TMO])) break; if (_sp > XB_SPIN_CAP) { atomicAdd(&(bar)[XB_TMO], 1u); break; } } } } while (0)

struct XcdBarrier {
    unsigned* bar; unsigned x;
    volatile LAS unsigned* st;
};

__device__ __forceinline__ XcdBarrier xcd_barrier_post(unsigned* bar, volatile LAS unsigned* st) {
    XcdBarrier b; b.bar = bar; b.x = xb_xcc_id(); b.st = st;
    if (threadIdx.x == 0) (void)xb_add(&bar[XB_XCNT(b.x)], 1u);
    return b;
}
__device__ __forceinline__ void xcd_barrier_complete(unsigned* bar, unsigned x, unsigned& nloc, unsigned& nx) {
    const unsigned G = gridDim.x * gridDim.y * gridDim.z;
    unsigned sum, cnt, mine, sp = 0u;
    for (;;) {
        sum = 0u; cnt = 0u; mine = 0u;
#pragma unroll
        for (unsigned j = 0; j < 16; ++j) { const unsigned c = xb_ld(&bar[XB_XCNT(j)]); sum += c; cnt += (c > 0u) ? 1u : 0u; mine = (j == x) ? c : mine; }
        if (sum == G) break;
        __builtin_amdgcn_s_sleep(1);
        if ((++sp & 255u) == 0u) { if (xb_ld(&bar[XB_TMO])) break; if (sp > XB_SPIN_CAP) { atomicAdd(&bar[XB_TMO], 1u); break; } }
    }
    nloc = mine > 0u ? mine : 1u; nx = cnt > 0u ? cnt : 1u;
}

__device__ __forceinline__ void xcd_barrier(const XcdBarrier& b) {
    asm volatile("s_waitcnt vmcnt(0)" ::: "memory");
    __syncthreads();
    if (threadIdx.x == 0) {
        unsigned* bar = b.bar;
        __builtin_amdgcn_s_waitcnt(0);
        unsigned nloc = b.st[0], nx = b.st[1];
        if (nloc == 0u) { xcd_barrier_complete(bar, b.x, nloc, nx); b.st[0] = nloc; b.st[1] = nx; }
        const unsigned old = xb_add(&bar[XB_XSUB(b.x)], 1u);
        const unsigned gen = old / nloc;
        if (old + 1u == (gen + 1u) * nloc) {
            __builtin_amdgcn_fence(__ATOMIC_RELEASE, "agent");
            asm volatile("s_waitcnt vmcnt(0)" ::: "memory");
            const unsigned og = xb_add(&bar[XB_TOP], 1u);
            const unsigned tg = og / nx;
            if (og + 1u == (tg + 1u) * nx) xb_add(&bar[XB_TOPGEN], 1u);
            else XB_SPIN(xb_ld(&bar[XB_TOPGEN]) == tg, bar);
            __builtin_amdgcn_fence(__ATOMIC_ACQUIRE, "agent");
            xb_add(&bar[XB_XGEN(b.x)], 1u);
            asm volatile("s_waitcnt vmcnt(0)" ::: "memory");
        } else {
            XB_SPIN(xb_ld(&bar[XB_XGEN(b.x)]) == gen, bar);
            __builtin_amdgcn_fence(__ATOMIC_ACQUIRE, "agent");
            asm volatile("s_waitcnt vmcnt(0)" ::: "memory");
        }
    }
    __syncthreads();
}


struct Args { const void* in[25]; float* out; unsigned char* ws; int ph_lo, ph_hi; };

struct Frame {
    LAS unsigned char* lds;
    int tid, lane, wave, vcu, G;
    unsigned char* ws;
};

__device__ __forceinline__ void transpose_item(const float* W, int N, int k0, int n0, bf16* WT, int ldt, int dst_row0, const float* gk, const float* gn, LAS float* scr, int lane) {
    const int c4 = lane & 7, r8 = lane >> 3, n = n0 + 4 * c4; const bool nv = n < N;
    f32x4 v[8]; float gkk[8];
#pragma unroll
    for (int i = 0; i < 8; ++i) { const int kk = r8 + 8 * i; v[i] = nv ? *(const f32x4*)(W + (size_t)(k0 + kk) * N + n) : (f32x4){0.f, 0.f, 0.f, 0.f}; gkk[i] = gk ? gk[k0 + kk] : 1.0f; }
    f32x4 sn = {1.f, 1.f, 1.f, 1.f}; if (gn && nv) sn = *(const f32x4*)(gn + n);
#pragma unroll
    for (int i = 0; i < 8; ++i) { const int kk = r8 + 8 * i; const f32x4 w = v[i] * gkk[i] * sn; LAS float* d = scr + kk * 33 + 4 * c4; d[0] = w[0]; d[1] = w[1]; d[2] = w[2]; d[3] = w[3]; }
    LDS_WAIT(); asm volatile("" ::: "memory");
    const int c = lane & 7;
#pragma unroll
    for (int j = 0; j < 4; ++j) { const int nn = (lane >> 3) + 8 * j; const LAS float* s = scr + (8 * c) * 33 + nn;
        u32x4 o; o.x = pk2(s[0 * 33], s[1 * 33]); o.y = pk2(s[2 * 33], s[3 * 33]); o.z = pk2(s[4 * 33], s[5 * 33]); o.w = pk2(s[6 * 33], s[7 * 33]);
        *(u32x4*)(WT + (size_t)(dst_row0 + nn) * ldt + k0 + 8 * c) = o; }
    LDS_WAIT(); asm volatile("" ::: "memory");
}
__device__ __forceinline__ void sincos_f(float a, float& cs, float& sn) {
    const float q = rintf(a * 0.636619772f); float r = fmaf(-q, 1.5707963705062866f, a); r = fmaf(-q, -4.37113883e-8f, r);
    const float r2 = r * r;
    const float sp = r * (1.0f + r2 * (-1.666666667e-1f + r2 * (8.333333333e-3f + r2 * (-1.984126984e-4f + r2 * 2.755731922e-6f))));
    const float cp = 1.0f + r2 * (-0.5f + r2 * (4.166666667e-2f + r2 * (-1.388888889e-3f + r2 * 2.480158730e-5f)));
    const int qi = ((int)q) & 3;
    sn = (qi == 0) ? sp : (qi == 1) ? cp : (qi == 2) ? -sp : -cp;
    cs = (qi == 0) ? cp : (qi == 1) ? -sp : (qi == 2) ? -cp : sp;
}
__device__ __forceinline__ float inv_freq(int j) {
    return j == 0 ? 0x1.0p+0f : j == 1 ? 0x1.8d275ep-3f : j == 2 ? 0x1.341190p-5f : j == 3 ? 0x1.ddee9cp-8f : j == 4 ? 0x1.72ba44p-10f : j == 5 ? 0x1.1f91f0p-12f : j == 6 ? 0x1.be2188p-15f : 0x1.5a0f4ep-17f;
}

__device__ __forceinline__ void phase_prologue(Frame& F, const Args& a) {
    const float* x = (const float*)a.in[0]; const float* p = (const float*)a.in[1]; const int* pos = (const int*)a.in[2];
    const float* norm_mix = (const float*)a.in[3]; const float* pool_w = (const float*)a.in[4]; const float* pool_scale = (const float*)a.in[5];
    const float* norm_kv = (const float*)a.in[6]; const float* w_kv = (const float*)a.in[7];
    const float* cmp_pos_k = (const float*)a.in[8]; const float* cmp_pos_v = (const float*)a.in[11]; const float* cmp_w1_k = (const float*)a.in[9]; const float* cmp_w1_v = (const float*)a.in[12];
    const float* w_in = (const float*)a.in[14]; const float* w_out = (const float*)a.in[15];
    const float* norm_ffn = (const float*)a.in[16]; const float* ffn_up = (const float*)a.in[17]; const float* ffn_down = (const float*)a.in[20];
    const float* norm_ple = (const float*)a.in[21]; const float* ple_gate = (const float*)a.in[22]; const float* ple_proj = (const float*)a.in[23];
    unsigned char* ws = F.ws;
    LAS float* scr = (LAS float*)(F.lds + F.wave * 16384);
    const int gw = F.vcu * NWAVES + F.wave, NGW = F.G * NWAVES;
    const int gt = gw * 64 + F.lane, NGT = NGW * 64;
    constexpr int I_UP = 16 * 176, I_DN = 44 * 32, I_G = 16 * 32, I_PP = 4 * 32, I_POOL = 4 * 8, I_KV = 16 * 48, I_IN = 16 * 34, I_OUT = 16 * 32, I_C1 = 32 * 4;
    constexpr int T_UP = 4 * I_UP, T_DN = 4 * I_DN, T_G = 4 * I_G, T_PP = 4 * I_PP, T_POOL = 8 * I_POOL, T_KV = I_KV, T_IN = 2 * I_IN, T_OUT = 2 * I_OUT, T_C1 = 2 * I_C1;
    constexpr int NITEMS = T_UP + T_DN + T_G + T_PP + T_POOL + T_KV + T_IN + T_OUT + T_C1;
    for (int it = gw; it < NITEMS; it += NGW) {
        int r = it;
        if (r < T_UP) { const int l = r / I_UP, q = r % I_UP, kb = q / 176, nb = q % 176, n0 = 32 * nb;
            const int dst = (n0 < FF) ? (n0 / 128) * 256 + (n0 % 128) : ((n0 - FF) / 128) * 256 + 128 + ((n0 - FF) % 128);
            transpose_item(ffn_up + (size_t)l * D * FF2, FF2, 64 * kb, n0, (bf16*)(ws + WS_WUP) + (size_t)l * FF2 * D, D, dst, norm_ffn + l * D, nullptr, scr, F.lane); continue; } r -= T_UP;
        if (r < T_DN) { const int l = r / I_DN, q = r % I_DN, kb = q / 32, nb = q % 32;
            transpose_item(ffn_down + (size_t)l * FF * D, D, 64 * kb, 32 * nb, (bf16*)(ws + WS_WDN) + (size_t)l * D * FF, FF, 32 * nb, nullptr, nullptr, scr, F.lane); continue; } r -= T_DN;
        if (r < T_G) { const int l = r / I_G, q = r % I_G, kb = q / 32, nb = q % 32;
            transpose_item(ple_gate + (size_t)l * D * D, D, 64 * kb, 32 * nb, (bf16*)(ws + WS_WG) + (size_t)l * D * D, D, 32 * nb, norm_ple + l * D, nullptr, scr, F.lane); continue; } r -= T_G;
        if (r < T_PP) { const int l = r / I_PP, q = r % I_PP, kb = q / 32, nb = q % 32;
            transpose_item(ple_proj + (size_t)l * PLE * D, D, 64 * kb, 32 * nb, (bf16*)(ws + WS_WPP) + (size_t)l * D * PLE, PLE, 32 * nb, nullptr, nullptr, scr, F.lane); continue; } r -= T_PP;
        if (r < T_POOL) { const int lg = r / I_POOL, q = r % I_POOL, kb = q / 8, nb = q % 8, l = lg >> 2, gi = lg & 3;
            transpose_item(pool_w + (size_t)lg * 256 * 256, 256, 64 * kb, 32 * nb, (bf16*)(ws + WS_WPOOL) + (size_t)l * D * 256, 256, gi * 256 + 32 * nb, nullptr, pool_scale + l * D + gi * 256, scr, F.lane); continue; } r -= T_POOL;
        if (r < T_KV) { const int kb = r / 48, nb = r % 48;
            transpose_item(w_kv, NKV, 64 * kb, 32 * nb, (bf16*)(ws + WS_WKVQ2), D, 32 * nb, norm_kv, nullptr, scr, F.lane); continue; } r -= T_KV;
        if (r < T_IN) { const int j = r / I_IN, q = r % I_IN, kb = q / 34, nb = q % 34;
            bf16* dstp = j == 0 ? (bf16*)(ws + WS_WKVQ2) + (size_t)NKV * D : (bf16*)(ws + WS_WQ3);
            transpose_item(w_in + (size_t)j * D * NQC, NQC, 64 * kb, 32 * nb, dstp, D, 32 * nb, norm_mix + (2 + j) * D, nullptr, scr, F.lane); continue; } r -= T_IN;
        if (r < T_OUT) { const int j = r / I_OUT, q = r % I_OUT, kb = q / 32, nb = q % 32;
            transpose_item(w_out + (size_t)j * D * D, D, 64 * kb, 32 * nb, (bf16*)(ws + WS_WOUT) + (size_t)j * D * D, D, 32 * nb, nullptr, nullptr, scr, F.lane); continue; } r -= T_OUT;
        { const int wh = r / I_C1, q = r % I_C1, kb = q / 4, nb = q % 4;
            transpose_item(wh ? cmp_w1_v : cmp_w1_k, 128, 64 * kb, 32 * nb, (bf16*)(ws + WS_WC1) + (size_t)wh * 256 * 2048, 2048, 32 * nb, nullptr, nullptr, scr, F.lane); }
    }
    {
        constexpr int Z1 = 192 * D / 8, Z3 = 128 * 2048 / 8;
        for (int i = gt; i < 2 * Z1 + 2 * Z3; i += NGT) {
            u32x4* dst;
            if (i < Z1) dst = (u32x4*)((bf16*)(ws + WS_WKVQ2) + (size_t)2624 * D) + i;
            else if (i < 2 * Z1) dst = (u32x4*)((bf16*)(ws + WS_WQ3) + (size_t)1088 * D) + (i - Z1);
            else if (i < 2 * Z1 + Z3) dst = (u32x4*)((bf16*)(ws + WS_WC1) + (size_t)128 * 2048) + (i - 2 * Z1);
            else dst = (u32x4*)((bf16*)(ws + WS_WC1) + (size_t)256 * 2048 + (size_t)128 * 2048) + (i - 2 * Z1 - Z3);
            unsigned zz = 0u; asm volatile("" : "+v"(zz)); const u32x4 z = {zz, zz, zz, zz};
            *dst = z;
        }
    }
    { const f32x4* src = (const f32x4*)p; u32x4* dst = (u32x4*)(ws + WS_PB); const int n8 = DEPTH * M * PLE / 8;
      for (int i0 = gt; i0 < n8; i0 += 4 * NGT) { f32x4 a0[4], a1[4];
#pragma unroll
          for (int u = 0; u < 4; ++u) { const int i = i0 + u * NGT; if (i < n8) { a0[u] = src[2 * i]; a1[u] = src[2 * i + 1]; } }
#pragma unroll
          for (int u = 0; u < 4; ++u) { const int i = i0 + u * NGT; if (i < n8) { u32x4 o; o.x = pk2(a0[u][0], a0[u][1]); o.y = pk2(a0[u][2], a0[u][3]); o.z = pk2(a1[u][0], a1[u][1]); o.w = pk2(a1[u][2], a1[u][3]); dst[i] = o; } } } }
    { float* rope = (float*)(ws + WS_ROPE);
      for (int i = gt; i < M * 8; i += NGT) { const int row = i >> 3, j = i & 7; const float ang = (float)pos[row] * inv_freq(j); float cs, sn; sincos_f(ang, cs, sn); rope[row * 16 + j] = cs; rope[row * 16 + 8 + j] = sn; }
      float* ropec = (float*)(ws + WS_ROPEC);
      for (int i = gt; i < NBATCH * 256 * 8; i += NGT) { const int j = i & 7, c = (i >> 3) & 255, b = i >> 11; float cs = 1.f, sn = 0.f;
          if (c < 255) { const float ang = (float)pos[b * SEQ + 16 * c + 31] * inv_freq(j); sincos_f(ang, cs, sn); }
          ropec[(b * 256 + c) * 16 + j] = cs; ropec[(b * 256 + c) * 16 + 8 + j] = sn; } }
    { float* cb1 = (float*)(ws + WS_CB1);
      for (int o = gw; o < 256; o += NGW) { const int wh = o >> 7, j = o & 127; float s = 0.f;
          const float* cp_ = wh ? cmp_pos_v : cmp_pos_k; const float* cw_ = wh ? cmp_w1_v : cmp_w1_k;
#pragma unroll 32
          for (int k = F.lane; k < 2048; k += 64) s += cp_[k] * cw_[(size_t)k * 128 + j];
          s = wave_sum(s); if (F.lane == 0) cb1[o] = s; } }
    { float* ssq = (float*)(ws + WS_SSQ0);
      for (int m0 = gw; m0 < M; m0 += 4 * NGW) { f32x4 v[4][4];
#pragma unroll
          for (int u = 0; u < 4; ++u) { const int m = m0 + u * NGW; if (m < M) { const f32x4* xr = (const f32x4*)(x + (size_t)m * D) + F.lane;
#pragma unroll
              for (int j = 0; j < 4; ++j) v[u][j] = xr[64 * j]; } }
#pragma unroll
          for (int u = 0; u < 4; ++u) { const int m = m0 + u * NGW; if (m < M) { float s = 0.f;
#pragma unroll
              for (int j = 0; j < 4; ++j) s += (v[u][j][0] * v[u][j][0] + v[u][j][1] * v[u][j][1]) + (v[u][j][2] * v[u][j][2] + v[u][j][3] * v[u][j][3]);
              s = wave_sum(s); if (F.lane == 0) { f32x4 o = {s, 0.f, 0.f, 0.f}; *(f32x4*)(ssq + (size_t)m * 4) = o; } } } } }
}

__device__ __forceinline__ void phase_poolprep(Frame& F, const float* xsrc, const float* ssq, const float* gmix, bf16* upool) {
    const int gw = F.vcu * NWAVES + F.wave, NGW = F.G * NWAVES;
    for (int task = gw; task < 4 * (M / 32); task += NGW) {
        const int j = task & 3, strip = task >> 2, t0 = strip * 32, bs = t0 & ~(SEQ - 1), W = 2 << j;
        const int col = 256 * j + 4 * F.lane;
        const f32x4 gv = *(const f32x4*)(gmix + col);
        f32x4 ring[16];
#pragma unroll
        for (int k = 0; k < 15; ++k) { const int tp = t0 - 15 + k; f32x4 hv = {0.f, 0.f, 0.f, 0.f};
            if (tp >= bs) { const float rs = row_rstd(ssq, tp); hv = *(const f32x4*)(xsrc + (size_t)tp * D + col) * rs * gv; }
            ring[(k + 1) & 15] = hv; }
#pragma unroll
        for (int i = 0; i < 32; ++i) { const int t = t0 + i; const float rs = row_rstd(ssq, t);
            const f32x4 hv = *(const f32x4*)(xsrc + (size_t)t * D + col) * rs * gv;
            ring[i & 15] = hv;
            f32x4 sum = hv;
#pragma unroll
            for (int k = 1; k < 16; ++k) if (k < W) sum += ring[(i - k) & 15];
            const int cnt = (t - bs + 1) < W ? (t - bs + 1) : W;
            const f32x4 u = sum * (1.0f / (float)cnt) - hv;
            u32x2 o; o.x = cvt_pk_bf16(u[0], u[1]); o.y = cvt_pk_bf16(u[2], u[3]);
            *(u32x2*)(upool + (size_t)t * D + col) = o; }
    }
}

__device__ __forceinline__ void phase_cmp2(Frame& F, const bf16* hid, const float* w2k, const float* w2v, const float* ropec, bf16* kc, bf16* vc) {
    const int gw = F.vcu * NWAVES + F.wave, NGW = F.G * NWAVES;
    LAS float* W2 = (LAS float*)F.lds;
    LAS float* hb = (LAS float*)(F.lds + 65536) + F.wave * 128;
    for (int i = F.tid; i < 2 * 128 * 64 / 4; i += NWAVES * 64) { const f32x4 v = (i < 2048) ? ((const f32x4*)w2k)[i] : ((const f32x4*)w2v)[i - 2048]; *(LAS f32x4*)(W2 + 4 * i) = v; }
    WG_BAR();
    for (int task = gw; task < 2 * 4096; task += NGW) {
        const int wh = task >> 12, row = task & 4095, c = row & 255, bg = row >> 8, b = bg >> 2, d = F.lane;
        const bf16* hr = hid + ((size_t)wh * 4096 + row) * 128;
        hb[d] = __uint_as_float(((unsigned)hr[d]) << 16); hb[64 + d] = __uint_as_float(((unsigned)hr[64 + d]) << 16);
        LDS_WAIT();
        const LAS float* w2 = W2 + wh * 8192 + d;
        float s = 0.f;
#pragma unroll 16
        for (int j = 0; j < 128; ++j) s += hb[j] * w2[j * 64];
        if (wh == 0) { const float partner = swz_xor<8>(s);
            if (d < 16) { const float cs = ropec[(b * 256 + c) * 16 + (d & 7)], sn = ropec[(b * 256 + c) * 16 + 8 + (d & 7)]; s = (d < 8) ? s * cs - partner * sn : s * cs + partner * sn; } }
        if (c == 255) s = 0.f;
        (wh ? vc : kc)[(size_t)row * 64 + d] = (bf16)f2bf(s);
        LDS_WAIT();
    }
    WG_BAR();
}

__device__ __forceinline__ void phase_final(Frame& F, float* x, const float* gfin) {
    const int gw = F.vcu * NWAVES + F.wave, NGW = F.G * NWAVES;
    for (int m = gw; m < M; m += NGW) { f32x4* xr = (f32x4*)(x + (size_t)m * D) + F.lane; f32x4 v[4]; float s = 0.f;
#pragma unroll
        for (int j = 0; j < 4; ++j) { v[j] = xr[64 * j]; s += (v[j][0] * v[j][0] + v[j][1] * v[j][1]) + (v[j][2] * v[j][2] + v[j][3] * v[j][3]); }
        const float rs = rsqrtf(wave_sum(s) * (1.0f / D) + EPS);
#pragma unroll
        for (int j = 0; j < 4; ++j) { const f32x4 gv = *((const f32x4*)gfin + F.lane + 64 * j); xr[64 * j] = v[j] * rs * gv; } }
}

#ifndef MK_CHECK
#define MK_CHECK 0
#endif
#ifndef MK_CHECK_SEL
#define MK_CHECK_SEL 0
#endif
#if MK_CHECK
constexpr int CW_CHK = 2048;
__device__ __forceinline__ float bf2f(bf16 v) { return __uint_as_float(((unsigned)v) << 16); }
__device__ __forceinline__ void chk_add(float* base, int which, float d2, float r2) {
    d2 = wave_sum(d2); r2 = wave_sum(r2);
    if ((threadIdx.x & 63) == 0) { atomicAdd(base + 2 * which, d2); atomicAdd(base + 2 * which + 1, r2); }
}
__device__ __forceinline__ float chk_dot(const float* xrow, float rs, const float* g, const float* W, int pitch, int col) {
    float s = 0.f; for (int k = 0; k < D; ++k) s += xrow[k] * rs * g[k] * W[(size_t)k * pitch + col]; return s;
}
__device__ __forceinline__ void check_proj(const Args& a, unsigned char* ws, int gtid, int ngt) {
    const float* X = a.out; const int* pos = (const int*)a.in[2]; const float* norm_mix2 = (const float*)a.in[3] + 2 * D; const float* norm_kv = (const float*)a.in[6];
    const float* w_kv = (const float*)a.in[7]; const float* w_in = (const float*)a.in[14];
    const bf16* KVB = (const bf16*)(ws + WS_KVB); const bf16* QO = (const bf16*)(ws + WS_QO); const float* GT = (const float*)(ws + WS_GATES);
    float* sums = (float*)(ws + WS_CTL) + CW_CHK;
    const int NS = 48, NC = NKV + NQC;
    float d2[4] = {0.f, 0.f, 0.f, 0.f}, r2[4] = {0.f, 0.f, 0.f, 0.f};
    for (int task = gtid; task < NS * NC; task += ngt) {
        const int i = task / NC, col = task % NC, row = (37 + 653 * i) % M; const float* xr = X + (size_t)row * D;
        float ss = 0.f; for (int k = 0; k < D; ++k) ss += xr[k] * xr[k];
        const float rs = rsqrtf(ss / D + EPS);
        const bool iskv = col < NKV; const int cq = col - NKV;
        const float* g = iskv ? norm_kv : norm_mix2; const float* W = iskv ? w_kv : w_in; const int pitch = iskv ? NKV : NQC; const int wc = iskv ? col : cq;
        float v = chk_dot(xr, rs, g, W, pitch, wc);
        const int d = wc & 63; bool roped = false;
        if (iskv) { const int t6 = col >> 8; roped = (t6 == 2 || t6 == 4) && d < 16; } else roped = (cq < 1024) && d < 16;
        if (roped) { const float v2 = chk_dot(xr, rs, g, W, pitch, d < 8 ? wc + 8 : wc - 8); float cs, sn; sincos_f((float)pos[row] * inv_freq(d & 7), cs, sn); v = d < 8 ? v * cs - v2 * sn : v * cs + v2 * sn; }
        float ref, got; int cat;
        if (iskv) { ref = v; got = bf2f(KVB[(size_t)row * NKV + col]); cat = roped ? 1 : 0; }
        else if (cq < 1024) { ref = v * QSCALE; got = bf2f(QO[(size_t)row * D + cq]); cat = 2; }
        else { ref = 1.0f / (1.0f + __expf(-v)); got = GT[(size_t)row * 48 + (cq - 1024)]; cat = 3; }
        const float df = got - ref;
#pragma unroll
        for (int c = 0; c < 4; ++c) if (cat == c) { d2[c] += df * df; r2[c] += ref * ref; }
    }
#pragma unroll
    for (int c = 0; c < 4; ++c) chk_add(sums, c, d2[c], r2[c]);
}
__device__ __forceinline__ void check_cmp(const Args& a, unsigned char* ws, int gwave, int ngw, int lane) {
    const int* pos = (const int*)a.in[2];
    const bf16* KVB = (const bf16*)(ws + WS_KVB); float* sums = (float*)(ws + WS_CTL) + CW_CHK;
    for (int smp = gwave; smp < 2 * 4 * 5; smp += ngw) {
        const int which = smp & 1, bgi = (smp >> 1) & 3, ci = smp >> 3; const int bg = bgi * 5, b = bg >> 2, g = bg & 3;
        const int c = ci == 0 ? 0 : ci == 1 ? 1 : ci == 2 ? 17 : ci == 3 ? 100 : 254;
        const float* cpos = (const float*)a.in[which ? 11 : 8]; const float* w1 = (const float*)a.in[which ? 12 : 9]; const float* w2 = (const float*)a.in[which ? 13 : 10];
        float h0 = 0.f, h1 = 0.f;
        for (int k = 0; k < 2048; ++k) { const int l = k >> 6, d = k & 63;
            const float z = bf2f(KVB[((size_t)b * SEQ + 16 * c + l) * NKV + which * 256 + g * 64 + d]) + cpos[k];
            h0 += z * w1[(size_t)k * 128 + lane]; h1 += z * w1[(size_t)k * 128 + 64 + lane]; }
        { const float y0 = 0.7978845608028654f * (h0 + 0.044715f * h0 * h0 * h0), y1 = 0.7978845608028654f * (h1 + 0.044715f * h1 * h1 * h1); h0 = h0 / (1.0f + __expf(-2.0f * y0)); h1 = h1 / (1.0f + __expf(-2.0f * y1)); }
        float o = 0.f;
        for (int j = 0; j < 64; ++j) { o += __shfl(h0, j) * w2[j * 64 + lane]; }
        for (int j = 0; j < 64; ++j) { o += __shfl(h1, j) * w2[(64 + j) * 64 + lane]; }
        if (which == 0) { const float partner = __shfl_xor(o, 8);
            if (lane < 16) { float cs, sn; sincos_f((float)pos[b * SEQ + 16 * c + 31] * inv_freq(lane & 7), cs, sn); o = lane < 8 ? o * cs - partner * sn : o * cs + partner * sn; } }
        const float got = bf2f(((const bf16*)(ws + (which ? WS_VC : WS_KC)))[((size_t)bg * 256 + c) * 64 + lane]);
        const float df = got - o; chk_add(sums, 4 + which, df * df, o * o);
    }
}
__device__ __forceinline__ void check_attn(unsigned char* ws, LAS unsigned char* lds, int wave, int gwave, int ngw, int lane) {
    const bf16* QO = (const bf16*)(ws + WS_QO); const bf16* KVB = (const bf16*)(ws + WS_KVB); const bf16* KC = (const bf16*)(ws + WS_KC); const bf16* VC = (const bf16*)(ws + WS_VC);
    const float* GT = (const float*)(ws + WS_GATES); const bf16* OB = (const bf16*)(ws + WS_XB); float* sums = (float*)(ws + WS_CTL) + CW_CHK;
    LAS float* P = (LAS float*)(lds + wave * 8192);
    LAS float* qbuf = P + 1024;
    LAS float* pbuf = qbuf + 64;
    LAS float* sbuf = pbuf + 64;
    for (int smp = gwave; smp < 24 * 8; smp += ngw) {
        const int ti = smp % 24, v8 = smp / 24;
        const int t = ti == 0 ? 0 : ti == 1 ? 5 : ti == 2 ? 30 : ti == 3 ? 31 : ti == 4 ? 47 : ti == 5 ? 63 : ti == 6 ? 64 : ti == 7 ? 100 : ti == 8 ? 511 : ti == 9 ? 512 : ti == 10 ? 513 : ti == 11 ? 1000 : ti == 12 ? 1023 : ti == 13 ? 1024 : ti == 14 ? 1025 : ti == 15 ? 1088 : ti == 16 ? 1500 : ti == 17 ? 2047 : ti == 18 ? 2048 : ti == 19 ? 2500 : ti == 20 ? 3000 : ti == 21 ? 3583 : ti == 22 ? 4000 : 4095;
        const int bg = (v8 * 7 + ti) & 15, b = bg >> 2, g = bg & 3, cur = t >> 6; const size_t rowg = (size_t)b * SEQ + t;
        const int cmax = t >= 31 ? (t - 31) >> 4 : -1;
        for (int hp = 0; hp < 4; ++hp) { const int head = 4 * g + hp;
            qbuf[lane] = bf2f(QO[rowg * D + head * 64 + lane]);
            float s[4]; float mx = -INFINITY;
#pragma unroll
            for (int j = 0; j < 4; ++j) { const int c = lane + 64 * j; s[j] = -INFINITY;
                if (c <= cmax) { float acc = 0.f; for (int d = 0; d < 64; ++d) acc += qbuf[d] * bf2f(KC[((size_t)bg * 256 + c) * 64 + d]); s[j] = acc; }
                mx = fmaxf(mx, s[j]); }
            for (int o = 1; o < 64; o <<= 1) mx = fmaxf(mx, __shfl_xor(mx, o));
            float e[4], sm = 0.f;
#pragma unroll
            for (int j = 0; j < 4; ++j) { e[j] = (lane + 64 * j <= cmax) ? __builtin_amdgcn_exp2f(s[j] - mx) : 0.f; sm += e[j]; }
            sm = wave_sum(sm);
#pragma unroll
            for (int j = 0; j < 4; ++j) P[hp * 256 + lane + 64 * j] = sm > 0.f ? e[j] / fmaxf(sm, 1e-30f) : 0.f;
        }
        float imp = 0.f; { const int n = lane; for (int hp = 0; hp < 4; ++hp) for (int c = 4 * n - 1; c <= 4 * n + 3; ++c) if (c >= 0 && c <= 254) imp += P[hp * 256 + c]; }
        const bool valid = lane <= cur, forced = (lane == 0) || (lane == cur) || (lane == cur - 1);
        const float score = valid ? (forced ? 1e4f : imp) : -1e30f;
        sbuf[lane] = score;
        int rank = 0; for (int n2 = 0; n2 < 64; ++n2) { const float v2 = sbuf[n2]; rank += ((v2 > score) || (v2 == score && n2 < lane)) ? 1 : 0; }
        const bool sel = (rank < 16) && (score > -5e29f);
        const unsigned long long selmask = __ballot(sel);
        for (int hp = 0; hp < 4; ++hp) { const int head = 4 * g + hp;
            qbuf[lane] = bf2f(QO[rowg * D + head * 64 + lane]);
            float oc = 0.f; for (int c = 0; c <= cmax; ++c) oc += P[hp * 256 + c] * bf2f(VC[((size_t)bg * 256 + c) * 64 + lane]);
            float outv = GT[rowg * 48 + head * 3 + 0] * oc;
            for (int br = 1; br < 3; ++br) {
                const bf16* kb = KVB + (size_t)b * SEQ * NKV + (br == 1 ? 512 : 1024) + g * 64; const bf16* vb = kb + 256;
                float m = -INFINITY, l = 0.f, o = 0.f;
                const int k0 = br == 1 ? 0 : (t - 511 > 0 ? t - 511 : 0);
                for (int ks = k0; ks <= t; ks += 64) {
                    if (br == 1 && !((selmask >> (ks >> 6)) & 1ull)) continue;
                    const int kpos = ks + lane; float s = -INFINITY;
                    if (kpos <= t) { float acc = 0.f; for (int d = 0; d < 64; ++d) acc += qbuf[d] * bf2f(kb[(size_t)kpos * NKV + d]); s = acc; }
                    float mt = s; for (int o2 = 1; o2 < 64; o2 <<= 1) mt = fmaxf(mt, __shfl_xor(mt, o2));
                    const float mn = fmaxf(m, mt), al = __builtin_amdgcn_exp2f(m - mn); const float pe = (kpos <= t) ? __builtin_amdgcn_exp2f(s - mn) : 0.f;
                    l = l * al + wave_sum(pe); pbuf[lane] = pe;
                    float acc = 0.f; for (int k = 0; k < 64; ++k) { const int kp = ks + k; if (kp <= t) acc += pbuf[k] * bf2f(vb[(size_t)kp * NKV + lane]); }
                    o = o * al + acc; m = mn;
                }
                outv += GT[rowg * 48 + head * 3 + br] * (o / l);
            }
            const float got = bf2f(OB[rowg * D + head * 64 + lane]); const float df = got - outv;
            chk_add(sums, 6, df * df, outv * outv);
        }
    }
}
#endif

enum PhaseKind { K_PRO = 0, K_PREP, K_POOLG, K_KVQ, K_CMP1, K_CMP2, K_ATT, K_WOUT, K_UP, K_DOWN, K_GATE, K_FINAL };
constexpr int NPHASES = 26;
#ifndef PH_MASK
#define PH_MASK 0xFFFF
#endif
#define PH_EN(k) (((PH_MASK) >> (k)) & 1)
#ifndef PROBE_KIND
#define PROBE_KIND -1
#endif
#ifndef PROBE_MULT
#define PROBE_MULT 4
#endif
__host__ __device__ __forceinline__ void decode_phase(int ph, int& kind, int& l) {
    if (ph == 0) { kind = K_PRO; l = 0; return; }
    if (ph >= 25) { kind = K_FINAL; l = 3; return; }
    int idx;
    if (ph < 6) { l = 0; idx = ph - 1; } else if (ph < 11) { l = 1; idx = ph - 6; } else if (ph < 19) { l = 2; idx = ph - 11; } else { l = 3; idx = ph - 19; }
    if (l < 2) { kind = idx == 0 ? K_PREP : idx == 1 ? K_POOLG : idx == 2 ? K_UP : idx == 3 ? K_DOWN : K_GATE; }
    else if (l == 2) { kind = idx == 0 ? K_KVQ : idx == 1 ? K_CMP1 : idx == 2 ? K_CMP2 : idx == 3 ? K_ATT : idx == 4 ? K_WOUT : idx == 5 ? K_UP : idx == 6 ? K_DOWN : K_GATE; }
    else { kind = idx == 0 ? K_KVQ : idx == 1 ? K_ATT : idx == 2 ? K_WOUT : idx == 3 ? K_UP : idx == 4 ? K_DOWN : K_GATE; }
}

struct CmpOrder {
    int c; const char* kvb; const char* wc1;
    __device__ __forceinline__ bool next(int i, pg8::Unit& u) const {
        if (i != 0 || c >= 32) return false;
        const int bg = c >> 1, which = c & 1, b = bg >> 2, g = bg & 3;
        u.pm = bg; u.pn = which; u.a = kvb + ((size_t)b * SEQ * NKV + which * 256 + g * 64) * 2; u.b = wc1 + (size_t)which * 256 * 2048 * 2; return true; }
    __device__ __forceinline__ void a_ready(const pg8::Unit&) const {}
    __device__ __forceinline__ void done(const pg8::Unit&) const {}
};

__global__ void __launch_bounds__(NWAVES * 64, 2) fwd_kernel(Args args) {
    extern __shared__ __attribute__((aligned(16))) unsigned char lds_raw[];
    LAS unsigned char* const lds0 = (LAS unsigned char*)lds_raw;
    volatile LAS unsigned* MISC = (volatile LAS unsigned*)(lds0 + MISC_OFF);
    const int wave_s = __builtin_amdgcn_readfirstlane((int)threadIdx.x >> 6);
    for (int u = threadIdx.x; u < (LDS_BYTES - LDSCTL_OFF) / 4; u += NWAVES * 64) ((LAS unsigned*)(lds0 + LDSCTL_OFF))[u] = 0u;
    __syncthreads();
    XcdBarrier bar; bar.bar = (unsigned*)((gu32*)(args.ws + WS_CTL) + CW_BAR); bar.x = 0; bar.st = nullptr;
    const int lo = args.ph_lo, hi = args.ph_hi;
    if (hi - lo > 1) bar = xcd_barrier_post((unsigned*)((gu32*)(args.ws + WS_CTL) + CW_BAR), MISC + 8);

    int ver = 0;
#define SSQ(v) ((float*)(ws + (((v) & 1) ? WS_SSQ1 : WS_SSQ0)))
    unsigned long long pr_acc = 0ull, pr_t0 = 0ull;
    for (int ph = 0; ph < hi; ++ph) {
        int kind, l; decode_phase(ph, kind, l);
        const bool run = ph >= lo;
        if (PROBE_KIND >= 0 && run && kind == PROBE_KIND) pr_t0 = __builtin_amdgcn_s_memrealtime();
        if (run) {
            int bx_l = blockIdx.x; asm volatile("" : "+s"(bx_l));
            unsigned char* ws = args.ws; asm volatile("" : "+s"(ws));
            const int G_l = gridDim.x, vcu_l = (G_l % 8 == 0) ? (bx_l % 8) * (G_l / 8) + bx_l / 8 : bx_l;
#define FRESH_TID(name) int name; { int z_ = 0; asm volatile("" : "+v"(z_)); name = wave_s * 64 + (int)__builtin_amdgcn_mbcnt_hi(~0u, __builtin_amdgcn_mbcnt_lo(~0u, (unsigned)z_)); }
#define MAKE_FRAME(F, t) Frame F; F.lds = lds0; F.tid = (t); F.lane = (t) & 63; F.wave = wave_s; F.G = G_l; F.vcu = vcu_l; F.ws = ws;
            const float* x_in = (const float*)args.in[0]; float* X = args.out;
            bf16* XB = (bf16*)(ws + WS_XB); bf16* XBG = (bf16*)(ws + WS_XBG); bf16* PP = (bf16*)(ws + WS_PP); bf16* HB = (bf16*)(ws + WS_H);
            bf16* KVB = (bf16*)(ws + WS_KVB); bf16* QO = (bf16*)(ws + WS_QO); bf16* UPOOL = (bf16*)(ws + WS_UPOOL);
            const int cblk = bx_l;
            if (PH_EN(K_PRO) && kind == K_PRO) { FRESH_TID(t_) MAKE_FRAME(F, t_) phase_prologue(F, args); }
            if (PH_EN(K_PREP) && kind == K_PREP) { FRESH_TID(t_) MAKE_FRAME(F, t_) phase_poolprep(F, l == 0 ? x_in : (const float*)X, SSQ(ver), (const float*)args.in[3] + l * D, UPOOL); }
            if (PH_EN(K_POOLG) && (kind == K_POOLG || kind == K_KVQ)) {
                pg8::Gemm g{PLE, PLE, 128, 128, 4};
                pg8::GridOrder S{64, 4, G_l, cblk, (const char*)(ws + WS_PB) + (size_t)l * M * PLE * 2, (const char*)(ws + WS_WPP) + (size_t)l * D * PLE * 2, (size_t)256 * PLE * 2, 0, (size_t)256 * PLE * 2, 1 << 30, 0};
                EpiPP E{PP};
                { FRESH_TID(t_)
                pg8::gemm_phase<EpiPP, pg8::GridOrder, true, true>(lds0, g, S, E, t_); }
            }
            if (PH_EN(K_KVQ) && kind == K_KVQ) {
                const int nN = (l == 2) ? 11 : 5;
                pg8::Gemm g{D, D, 128, 128, 16};
                pg8::GridOrder S{64, nN, G_l, cblk, (const char*)XBG, (const char*)(ws + (l == 2 ? WS_WKVQ2 : WS_WQ3)), (size_t)256 * D * 2, 0, (size_t)256 * D * 2, 1 << 30, 0};
                EpiKVQ E{SSQ(ver), (const float*)(ws + WS_ROPE), KVB, QO, (float*)(ws + WS_GATES), (l == 2) ? 6 : 0};
                { FRESH_TID(t_)
                pg8::gemm_phase<EpiKVQ, pg8::GridOrder, true, true>(lds0, g, S, E, t_); }
            }
            if (PH_EN(K_CMP1) && kind == K_CMP1) {
                pg8::Gemm g{16 * NKV, 2048, NKV * 2, 128, 32};
                CmpOrder S{cblk, (const char*)KVB, (const char*)(ws + WS_WC1)};
                EpiCMP E{(const float*)(ws + WS_CB1), (bf16*)(ws + WS_HID)};
                { FRESH_TID(t_)
                pg8::gemm_phase<EpiCMP, CmpOrder, true, true>(lds0, g, S, E, t_); }
            }
            if (PH_EN(K_CMP2) && kind == K_CMP2) { FRESH_TID(t_) MAKE_FRAME(F, t_) phase_cmp2(F, (const bf16*)(ws + WS_HID), (const float*)args.in[10], (const float*)args.in[13], (const float*)(ws + WS_ROPEC), (bf16*)(ws + WS_KC), (bf16*)(ws + WS_VC)); }
            if (PH_EN(K_ATT) && kind == K_ATT) {
                att::Tensors T{QO, KVB, (const bf16*)(ws + WS_KC), (const bf16*)(ws + WS_VC), (const float*)(ws + WS_GATES), MK_CHECK ? XB : QO};
                const int bgi = (vcu_l >> 4) & 15, s = vcu_l & 15;
                for (int i = 0; i < 4; ++i) { const int qb = (i == 0) ? s : (i == 1) ? 31 - s : (i == 2) ? 32 + s : 63 - s;
                    FRESH_TID(t_) att::unit(T, bgi >> 2, bgi & 3, qb, (LAS char*)lds0, t_); }
            }
            if (PH_EN(K_DOWN) && (kind == K_POOLG || kind == K_WOUT || kind == K_DOWN)) {
                pg8::Gemm g; pg8::GridOrder S; S.nM = 64; S.nN = 4; S.G = G_l; S.c = cblk; S.pm_div = 1 << 30; S.b_pm = 0;
                const float* xold = X;
                if (kind == K_POOLG) { g = pg8::Gemm{D, 256, 128, 128, 4}; S.A = (const char*)UPOOL; S.a_tile = (size_t)256 * D * 2; S.a_pn = 512; S.B = (const char*)(ws + WS_WPOOL) + (size_t)l * D * 256 * 2; S.b_tile = (size_t)256 * 256 * 2; if (l == 0) xold = x_in; }
                else if (kind == K_WOUT) { g = pg8::Gemm{D, D, 128, 128, 16}; S.A = (const char*)QO; S.a_tile = (size_t)256 * D * 2; S.a_pn = 0; S.B = (const char*)(ws + WS_WOUT) + (size_t)(l - 2) * D * D * 2; S.b_tile = (size_t)256 * D * 2; }
                else { g = pg8::Gemm{FF, FF, 128, 128, 44}; S.A = (const char*)HB; S.a_tile = (size_t)256 * FF * 2; S.a_pn = 0; S.B = (const char*)(ws + WS_WDN) + (size_t)l * D * FF * 2; S.b_tile = (size_t)256 * FF * 2; }
                EpiX<0> E{xold, X, XB, SSQ(ver + 1), nullptr, nullptr};
                { FRESH_TID(t_)
                pg8::gemm_phase<EpiX<0>, pg8::GridOrder, false, true>(lds0, g, S, E, t_); }
            }
            if (PH_EN(K_UP) && kind == K_UP) {
                pg8::Gemm g{D, D, 128, 128, 16};
                EpiUP E{SSQ(ver), (const float*)args.in[18] + (size_t)l * 3 * FF2, (const float*)args.in[19] + (size_t)l * FF2, HB};
                for (int i = 0;; ++i) {
                    int pm, pn; if (!pg8::tile_order(NUPM, 22, G_l, cblk, i, pm, pn)) break;
                    pg8::OneUnit S; S.valid = true; S.u.pm = pm; S.u.pn = pn;
                    S.u.a = (const char*)XB + ((long)UPM * pm - 2) * (long)(D * 2); S.u.b = (const char*)(ws + WS_WUP) + ((size_t)l * FF2 + (size_t)pn * 256) * D * 2;
                    { FRESH_TID(t_)
                    pg8::gemm_phase<EpiUP, pg8::OneUnit, false, true>(lds0, g, S, E, t_); }
                }
            }
            if (PH_EN(K_GATE) && kind == K_GATE) {
                pg8::Gemm g{D, D, 128, 128, 16};
                pg8::GridOrder S{64, 4, G_l, cblk, (const char*)XB, (const char*)(ws + WS_WG) + (size_t)l * D * D * 2, (size_t)256 * D * 2, 0, (size_t)256 * D * 2, 1 << 30, 0};
                EpiX<1> E{X, X, XBG, SSQ(ver + 1), SSQ(ver), PP};
                { FRESH_TID(t_)
                pg8::gemm_phase<EpiX<1>, pg8::GridOrder, false, true>(lds0, g, S, E, t_); }
            }
                        if (PH_EN(K_FINAL) && kind == K_FINAL) { FRESH_TID(t_) MAKE_FRAME(F, t_) phase_final(F, X, (const float*)args.in[24]); }
            if (ph + 1 < hi) { XcdBarrier b2 = bar; asm volatile("" : "+s"(b2.bar)); xcd_barrier(b2); }
        }
        if (PROBE_KIND >= 0 && run && kind == PROBE_KIND) pr_acc += __builtin_amdgcn_s_memrealtime() - pr_t0;
        if (kind == K_POOLG || kind == K_WOUT || kind == K_DOWN || kind == K_GATE) ++ver;
    }
    if (PROBE_KIND >= 0 && blockIdx.x == 0) { const unsigned long long te = __builtin_amdgcn_s_memrealtime(); while (__builtin_amdgcn_s_memrealtime() - te < (unsigned long long)PROBE_MULT * pr_acc) __builtin_amdgcn_s_sleep(32); }
}

#if MK_CHECK
__global__ void __launch_bounds__(512) check_kernel(Args args) {
    extern __shared__ __attribute__((aligned(16))) unsigned char lds_raw[];
    LAS unsigned char* const lds0 = (LAS unsigned char*)lds_raw;
    unsigned char* ws = args.ws; const int tid = threadIdx.x, lane = tid & 63, wave = tid >> 6, bx = blockIdx.x, G = gridDim.x;
    float* sums = (float*)(ws + WS_CTL) + CW_CHK;
    check_proj(args, ws, bx * 512 + tid, G * 512);
    check_cmp(args, ws, bx * 8 + wave, G * 8, lane);
    check_attn(ws, lds0, wave, bx * 8 + wave, G * 8, lane);
    __syncthreads();
    if (tid == 0) { __threadfence(); atomicAdd((unsigned*)(ws + WS_CTL) + CW_CHK + 64, 1u); while (__hip_atomic_load((unsigned*)(ws + WS_CTL) + CW_CHK + 64, __ATOMIC_RELAXED, __HIP_MEMORY_SCOPE_AGENT) < (unsigned)G) __builtin_amdgcn_s_sleep(8); __threadfence(); }
    __syncthreads();
    const float sd = __hip_atomic_load(sums + 2 * MK_CHECK_SEL, __ATOMIC_RELAXED, __HIP_MEMORY_SCOPE_AGENT), sr = __hip_atomic_load(sums + 2 * MK_CHECK_SEL + 1, __ATOMIC_RELAXED, __HIP_MEMORY_SCOPE_AGENT);
    const float cval = sr > 0.f ? 1e4f * sqrtf(sd / sr) : 7e7f;
    for (int i = bx * 512 + tid; i < M * D; i += G * 512) args.out[i] = cval;
}
#endif

extern "C" void kernel_launch(void* const* d_in, const int* in_sizes, int n_in, void* d_out, int out_size, void* d_ws, size_t ws_size, hipStream_t stream) {
    static int grid = 0;
    if (grid == 0) {
        if (n_in != 25 || out_size != M * D || ws_size < WS_END) { fprintf(stderr, "kernel_launch: unexpected shapes (n_in %d, out %d, ws %zu < %zu); nothing launched\n", n_in, out_size, ws_size, (size_t)WS_END); grid = -1; return; }
        int dev = 0, cus = 0, per_cu = 0;
        if (hipGetDevice(&dev) != hipSuccess || hipDeviceGetAttribute(&cus, hipDeviceAttributeMultiprocessorCount, dev) != hipSuccess) { grid = -1; return; }
        if (hipFuncSetAttribute((const void*)fwd_kernel, hipFuncAttributeMaxDynamicSharedMemorySize, LDS_BYTES) != hipSuccess) { fprintf(stderr, "kernel_launch: hipFuncSetAttribute failed\n"); grid = -1; return; }
        if (hipOccupancyMaxActiveBlocksPerMultiprocessor(&per_cu, (const void*)fwd_kernel, NWAVES * 64, LDS_BYTES) != hipSuccess || per_cu < 1) fprintf(stderr, "kernel_launch: occupancy query reports %d\n", per_cu);
        (void)hipGetLastError();
        grid = 256;
        if (cus != 256) fprintf(stderr, "kernel_launch: device has %d CUs, kernel is built for 256\n", cus);
    }
    if (grid < 0) return;
    if (hipMemsetAsync((char*)d_ws + WS_CTL, 0, CTL_ZERO_BYTES, stream) != hipSuccess) return;
    Args a{};
    for (int i = 0; i < 25; ++i) a.in[i] = d_in[i];
    a.out = (float*)d_out; a.ws = (unsigned char*)d_ws;
#if MK_PER_PHASE
    for (int ph = 0; ph < NPHASES; ++ph) { a.ph_lo = ph; a.ph_hi = ph + 1; hipLaunchKernelGGL(fwd_kernel, dim3(grid), dim3(NWAVES * 64), LDS_BYTES, stream, a); }
#elif MK_CHECK
    a.ph_lo = 0; a.ph_hi = 15;
    hipLaunchKernelGGL(fwd_kernel, dim3(grid), dim3(NWAVES * 64), LDS_BYTES, stream, a);
    hipLaunchKernelGGL(check_kernel, dim3(grid), dim3(512), 65536, stream, a);
#else
    a.ph_lo = 0; a.ph_hi = NPHASES;
    hipLaunchKernelGGL(fwd_kernel, dim3(grid), dim3(NWAVES * 64), LDS_BYTES, stream, a);
#endif
}
```

```cpp
#include <hip/hip_runtime.h>
#include <hip/hip_bf16.h>
#include <cstdio>
#include <cstdint>
#include <cmath>

#ifndef MK_PER_PHASE
#define MK_PER_PHASE 0
#endif

namespace pg8 {
#define PG8_LAS __attribute__((address_space(3)))
typedef unsigned short bf16_t;
typedef short bf16x8 __attribute__((ext_vector_type(8)));
typedef float f32x4 __attribute__((ext_vector_type(4)));
typedef unsigned u32x4 __attribute__((ext_vector_type(4)));
typedef unsigned u32x2 __attribute__((ext_vector_type(2)));
constexpr int BM = 256, BK = 64, HALF = 128, HTB = HALF * BK * 2, STAGE_BYTES = 8 * HTB, NXCD = 8, WGM = 8;

__host__ __device__ __forceinline__ int lds_byte(int r, int c) { const int st = (r >> 4) * 2 + (c >> 5), rr = r & 15, cc = c & 31, ob = rr * 64 + cc * 2; return st * 1024 + (ob ^ (((ob >> 9) & 1) << 5)); }
__host__ __device__ __forceinline__ void stage_rc(int b, int& R, int& C) { const int st = b / 1024, sb = b % 1024, swz = sb ^ (((sb >> 9) & 1) << 5); R = (st >> 1) * 16 + swz / 64; C = (st & 1) * 32 + (swz % 64) / 2; }
__host__ __device__ __forceinline__ int perm32(int rho) { const int n = rho >> 4, i = rho & 15; return 8 * (i >> 2) + 4 * n + (i & 3); }

struct Unit { int pm, pn; const char* a; const char* b; };
struct Gemm { int lda, ldb; int kstepA, kstepB; int nt; };

__device__ __forceinline__ bool tile_order(int nM, int nN, int G, int c, int i, int& pm, int& pn) {
    const int nwg = nM * nN; const long L = (long)i * G + c; if (L >= nwg) return false;
    int wgid = (int)L; { const int q = nwg / NXCD, r = nwg % NXCD, xcd = wgid % NXCD, off = wgid / NXCD; wgid = (xcd < r ? xcd * (q + 1) : r * (q + 1) + (xcd - r) * q) + off; }
    const int nig = WGM * nN, gid = wgid / nig, fm = gid * WGM, gsz = (nM - fm) < WGM ? (nM - fm) : WGM;
    pm = fm + ((wgid % nig) % gsz); pn = (wgid % nig) / gsz; return true;
}
struct GridOrder {
    int nM, nN, G, c; const char* A; const char* B; size_t a_tile, a_pn, b_tile; int pm_div; size_t b_pm;
    __device__ __forceinline__ bool next(int i, Unit& u) const {
        int pm, pn; if (!tile_order(nM, nN, G, c, i, pm, pn)) return false;
        u.pm = pm; u.pn = pn; u.a = A + (size_t)pm * a_tile + (size_t)pn * a_pn; u.b = B + (size_t)pn * b_tile + (size_t)(pm / pm_div) * b_pm; return true; }
    __device__ __forceinline__ void a_ready(const Unit&) const {}
    __device__ __forceinline__ void done(const Unit&) const {}
};
struct OneUnit { Unit u; bool valid;
    __device__ __forceinline__ bool next(int i, Unit& o) const { if (i != 0 || !valid) return false; o = u; return true; }
    __device__ __forceinline__ void a_ready(const Unit&) const {}
    __device__ __forceinline__ void done(const Unit&) const {}
};
__device__ __forceinline__ unsigned cvt_pk_bf16(float lo, float hi) { unsigned r; asm volatile("v_cvt_pk_bf16_f32 %0, %1, %2" : "=v"(r) : "v"(lo), "v"(hi)); return r; }
__device__ __forceinline__ float bf_lo(unsigned w) { return __uint_as_float(w << 16); }
__device__ __forceinline__ float bf_hi(unsigned w) { return __uint_as_float(w & 0xffff0000u); }
__device__ __forceinline__ float sigmoidf_(float v) { return 1.0f / (1.0f + __expf(-v)); }

template <class Epi, class Sched, bool ALIGN_EPI = false, bool SP2 = false>
__device__ __forceinline__ void gemm_phase(PG8_LAS unsigned char* lds, const Gemm g, const Sched& S, const Epi& E, const int tid) {
    const int wid = __builtin_amdgcn_readfirstlane(tid >> 6), lane = tid & 63, wr = wid >> 2, wc = wid & 3, fr = lane & 15, fq = lane >> 4;
    const int nt = g.nt;
    unsigned voffA[2], voffB[2];
#pragma unroll
    for (int i = 0; i < 2; ++i) { int R, C; stage_rc(tid * 16 + i * 8192, R, C); const int Rb = Epi::PERM ? ((R & ~31) + perm32(R & 31)) : R;
        voffA[i] = (unsigned)(R * g.lda + C) * 2u; voffB[i] = (unsigned)(Rb * g.ldb + C) * 2u; }
    const unsigned kstepA = (unsigned)g.kstepA, kstepB = (unsigned)g.kstepB;
    const unsigned hstepA = (unsigned)(HALF * g.lda * 2), hstepB = (unsigned)(HALF * g.ldb * 2);
    const unsigned ldsw = (unsigned)wid * 1024u;
    const int aoff = lds_byte(wr * 64 + fr, fq * 8), boff = lds_byte(wc * 32 + fr, fq * 8);
#define PG8_SA(b, h) (((b) * 2 + (h)) * HTB)
#define PG8_SB(b, h) ((4 + (b) * 2 + (h)) * HTB)
#define PG8_STAGE(bufoff, gbase, voff) do { _Pragma("unroll") for (int _i = 0; _i < 2; ++_i) \
        __builtin_amdgcn_global_load_lds((const unsigned*)((const char*)(gbase) + (voff)[_i]), (PG8_LAS unsigned*)(lds + (bufoff) + ldsw + _i * 8192), 16, 0, 0); } while (0)
#define PG8_LDA(dst, b, h) do { _Pragma("unroll") for (int m = 0; m < 4; ++m) _Pragma("unroll") for (int k = 0; k < 2; ++k) dst[m][k] = *(const PG8_LAS bf16x8*)(lds + PG8_SA(b, h) + aoff + m * 2048 + k * 1024); } while (0)
#define PG8_LDB(dst, b, h) do { _Pragma("unroll") for (int n = 0; n < 2; ++n) _Pragma("unroll") for (int k = 0; k < 2; ++k) dst[n][k] = *(const PG8_LAS bf16x8*)(lds + PG8_SB(b, h) + boff + n * 2048 + k * 1024); } while (0)
#define PG8_MMA(ai, bj, At, Bt) do { __builtin_amdgcn_s_setprio(1); _Pragma("unroll") for (int m = 0; m < 4; ++m) _Pragma("unroll") for (int n = 0; n < 2; ++n) _Pragma("unroll") for (int k = 0; k < 2; ++k) \
        acc[ai][bj][m][n] = __builtin_amdgcn_mfma_f32_16x16x32_bf16(Bt[n][k], At[m][k], acc[ai][bj][m][n], 0, 0, 0); __builtin_amdgcn_s_setprio(0); } while (0)
#define PG8_WAIT_V(n) asm volatile("s_waitcnt vmcnt(" #n ")" ::: "memory")
#define PG8_WAIT_L(n) asm volatile("s_waitcnt lgkmcnt(" #n ")" ::: "memory")
#define PG8_BAR __builtin_amdgcn_s_barrier()
#define PG8_SCHED __builtin_amdgcn_sched_barrier(0)
    Unit cur, nxt; int ui = 0;
    if (!S.next(0, cur)) return;
    f32x4 acc[2][2][4][2];
#pragma unroll
    for (int a = 0; a < 2; ++a)
#pragma unroll
        for (int b = 0; b < 2; ++b)
#pragma unroll
            for (int m = 0; m < 4; ++m)
#pragma unroll
                for (int n = 0; n < 2; ++n) acc[a][b][m][n] = (f32x4){0.f, 0.f, 0.f, 0.f};
    bf16x8 At[4][2], B0[2][2], B1[2][2];
    const char* cA = cur.a; const char* cB = cur.b;
    S.a_ready(cur);
    if constexpr (SP2) {
        PG8_STAGE(PG8_SB(0, 0), cB, voffB); PG8_STAGE(PG8_SB(0, 1), cB + hstepB, voffB); PG8_STAGE(PG8_SA(0, 0), cA, voffA); PG8_STAGE(PG8_SA(0, 1), cA + hstepA, voffA);
        if (wr == 1) PG8_BAR;
        PG8_WAIT_V(2); PG8_BAR;
        PG8_STAGE(PG8_SB(1, 0), cB + kstepB, voffB); PG8_STAGE(PG8_SA(1, 0), cA + kstepA, voffA); PG8_STAGE(PG8_SB(1, 1), cB + hstepB + kstepB, voffB);
        PG8_WAIT_V(6); PG8_BAR;
    } else {
        PG8_STAGE(PG8_SB(0, 0), cB, voffB); PG8_STAGE(PG8_SA(0, 0), cA, voffA); PG8_STAGE(PG8_SB(0, 1), cB + hstepB, voffB); PG8_STAGE(PG8_SA(0, 1), cA + hstepA, voffA);
        if (wr == 1) PG8_BAR;
        PG8_WAIT_V(4); PG8_BAR;
        PG8_STAGE(PG8_SB(1, 0), cB + kstepB, voffB); PG8_STAGE(PG8_SA(1, 0), cA + kstepA, voffA); PG8_STAGE(PG8_SB(1, 1), cB + hstepB + kstepB, voffB);
        PG8_WAIT_V(6); PG8_BAR;
    }
    for (;;) {
        const bool has_next = S.next(ui + 1, nxt);
        const char* nA = has_next ? nxt.a : cA; const char* nB = has_next ? nxt.b : cB;
        for (int t = 0; t < nt; t += 2) {
            const bool last = (t == nt - 2);
            const char* a1 = cA + (size_t)((unsigned)(t + 1) * kstepA);
            const char* a2 = last ? nA : cA + (size_t)((unsigned)(t + 2) * kstepA); const char* b2 = last ? nB : cB + (size_t)((unsigned)(t + 2) * kstepB);
            const char* a3 = a2 + kstepA; const char* b3 = b2 + kstepB;
            if (last && has_next) S.a_ready(nxt);
            if constexpr (SP2) {
            PG8_LDB(B0, 0, 0); PG8_LDB(B1, 0, 1); PG8_SCHED; PG8_LDA(At, 0, 0); PG8_STAGE(PG8_SA(1, 1), a1 + hstepA, voffA);
            PG8_WAIT_V(8); PG8_WAIT_L(0); PG8_BAR; PG8_MMA(0, 0, At, B0); PG8_MMA(0, 1, At, B1); PG8_BAR; PG8_SCHED;
            PG8_LDA(At, 0, 1); PG8_STAGE(PG8_SB(0, 0), b2, voffB); PG8_STAGE(PG8_SB(0, 1), b2 + hstepB, voffB); PG8_STAGE(PG8_SA(0, 0), a2, voffA);
            PG8_WAIT_V(8); PG8_WAIT_L(0); PG8_BAR; PG8_MMA(1, 0, At, B0); PG8_MMA(1, 1, At, B1); PG8_BAR; PG8_SCHED;
            PG8_LDB(B0, 1, 0); PG8_LDB(B1, 1, 1); PG8_SCHED; PG8_LDA(At, 1, 0); PG8_STAGE(PG8_SA(0, 1), a2 + hstepA, voffA);
            PG8_WAIT_V(8); PG8_WAIT_L(0); PG8_BAR; PG8_MMA(0, 0, At, B0); PG8_MMA(0, 1, At, B1); PG8_BAR; PG8_SCHED;
            PG8_LDA(At, 1, 1); PG8_STAGE(PG8_SB(1, 0), b3, voffB); PG8_STAGE(PG8_SB(1, 1), b3 + hstepB, voffB); PG8_STAGE(PG8_SA(1, 0), a3, voffA);
            PG8_WAIT_V(8); PG8_WAIT_L(0); PG8_BAR; PG8_MMA(1, 0, At, B0); PG8_MMA(1, 1, At, B1); PG8_BAR; PG8_SCHED;
            } else {
            PG8_LDB(B0, 0, 0); PG8_SCHED; PG8_LDA(At, 0, 0); PG8_STAGE(PG8_SA(1, 1), a1 + hstepA, voffA);
            PG8_WAIT_L(8); PG8_BAR; PG8_WAIT_L(0); PG8_MMA(0, 0, At, B0); PG8_BAR; PG8_SCHED;
            PG8_LDB(B1, 0, 1); PG8_STAGE(PG8_SB(0, 0), b2, voffB);
            PG8_BAR; PG8_WAIT_L(0); PG8_MMA(0, 1, At, B1); PG8_BAR;
            PG8_LDA(At, 0, 1); PG8_STAGE(PG8_SA(0, 0), a2, voffA);
            PG8_BAR; PG8_WAIT_L(0); PG8_MMA(1, 0, At, B0); PG8_BAR; PG8_SCHED;
            PG8_STAGE(PG8_SB(0, 1), b2 + hstepB, voffB);
            PG8_WAIT_V(6); PG8_BAR; PG8_MMA(1, 1, At, B1); PG8_BAR;
            PG8_LDB(B0, 1, 0); PG8_SCHED; PG8_LDA(At, 1, 0); PG8_STAGE(PG8_SA(0, 1), a2 + hstepA, voffA);
            PG8_WAIT_L(8); PG8_BAR; PG8_WAIT_L(0); PG8_MMA(0, 0, At, B0); PG8_BAR; PG8_SCHED;
            PG8_LDB(B1, 1, 1); PG8_STAGE(PG8_SB(1, 0), b3, voffB);
            PG8_BAR; PG8_WAIT_L(0); PG8_MMA(0, 1, At, B1); PG8_BAR;
            PG8_LDA(At, 1, 1); PG8_STAGE(PG8_SA(1, 0), a3, voffA);
            PG8_BAR; PG8_WAIT_L(0); PG8_MMA(1, 0, At, B0); PG8_BAR; PG8_SCHED;
            PG8_STAGE(PG8_SB(1, 1), b3 + hstepB, voffB);
            PG8_WAIT_V(6); PG8_BAR; PG8_MMA(1, 1, At, B1); PG8_BAR;
            }
        }
        if constexpr (ALIGN_EPI) { if (wr == 0) PG8_BAR; }
        if constexpr (!Epi::AFTER_DRAIN) { int z_e = 0; asm volatile("" : "+v"(z_e)); const int lane_e = (int)__builtin_amdgcn_mbcnt_hi(~0u, __builtin_amdgcn_mbcnt_lo(~0u, (unsigned)z_e)); const int fr_e = lane_e & 15, fq_e = lane_e >> 4; E(acc, cur, wr, wc, fr_e, fq_e); S.done(cur); }
        if (!has_next) break;
#pragma unroll
        for (int a = 0; a < 2; ++a)
#pragma unroll
            for (int b = 0; b < 2; ++b)
#pragma unroll
                for (int m = 0; m < 4; ++m)
#pragma unroll
                    for (int n = 0; n < 2; ++n) acc[a][b][m][n] = (f32x4){0.f, 0.f, 0.f, 0.f};
        cur = nxt; cA = nA; cB = nB; ++ui;
        if constexpr (ALIGN_EPI) { if (wr == 1) PG8_BAR; }
    }
    PG8_WAIT_V(0);
    if constexpr (!ALIGN_EPI) { if (wr == 0) PG8_BAR; }
    PG8_BAR;
    if constexpr (Epi::AFTER_DRAIN) { int z_e = 0; asm volatile("" : "+v"(z_e)); const int lane_e = (int)__builtin_amdgcn_mbcnt_hi(~0u, __builtin_amdgcn_mbcnt_lo(~0u, (unsigned)z_e)); const int fr_e = lane_e & 15, fq_e = lane_e >> 4; E.fused(acc, cur, wr, wc, fr_e, fq_e, lds, wid, lane_e); S.done(cur); }
#undef PG8_SA
#undef PG8_SB
#undef PG8_STAGE
#undef PG8_LDA
#undef PG8_LDB
#undef PG8_MMA
#undef PG8_WAIT_V
#undef PG8_WAIT_L
#undef PG8_BAR
#undef PG8_SCHED
}

}

constexpr int M = 16384, D = 1024, SEQ = 4096, NBATCH = 4, DEPTH = 4, FF = 2816, FF2 = 5632, PLE = 256;
constexpr int NKV = 1536, NQC = 1072;
constexpr float EPS = 1e-6f;
constexpr float QSCALE = 0.125f * 1.4426950408889634f;
constexpr int UPM = 254;
constexpr int NUPM = (M + UPM - 1) / UPM;
constexpr int TPITCH = 264;

#define GAS __attribute__((address_space(1)))
#define LAS __attribute__((address_space(3)))
typedef unsigned short bf16;
typedef float f32x4 __attribute__((ext_vector_type(4)));
typedef float f32x16 __attribute__((ext_vector_type(16)));
typedef short bf16x8 __attribute__((ext_vector_type(8)));
typedef short s16x4 __attribute__((ext_vector_type(4)));
typedef unsigned u32x4 __attribute__((ext_vector_type(4)));
typedef unsigned u32x2 __attribute__((ext_vector_type(2)));
using pg8::cvt_pk_bf16; using pg8::bf_lo; using pg8::bf_hi; using pg8::sigmoidf_;


template <int MASK> __device__ __forceinline__ float swz_xor(float v) { return __uint_as_float((unsigned)__builtin_amdgcn_ds_swizzle((int)__float_as_uint(v), 0x1F | (MASK << 10))); }
template <int MASK> __device__ __forceinline__ unsigned swz_xor_u(unsigned v) { return (unsigned)__builtin_amdgcn_ds_swizzle((int)v, 0x1F | (MASK << 10)); }
__device__ __forceinline__ float xor32_sum(float v) { auto rr = __builtin_amdgcn_permlane32_swap(__float_as_uint(v), __float_as_uint(v), false, false); return __uint_as_float(rr[0]) + __uint_as_float(rr[1]); }
__device__ __forceinline__ float xor32_max(float v) { auto rr = __builtin_amdgcn_permlane32_swap(__float_as_uint(v), __float_as_uint(v), false, false); return fmaxf(__uint_as_float(rr[0]), __uint_as_float(rr[1])); }
__device__ __forceinline__ float xor32_other(float v, int hi) { auto rr = __builtin_amdgcn_permlane32_swap(__float_as_uint(v), __float_as_uint(v), false, false); return __uint_as_float(hi ? rr[0] : rr[1]); }

__device__ __forceinline__ float row_rstd(const float* ssq, int row) {
    const f32x4 s = *(const f32x4*)(ssq + 4 * (size_t)row);
    return rsqrtf(((s[0] + s[1]) + (s[2] + s[3])) * (1.0f / 1024.0f) + EPS);
}
#define WG_BAR() do { asm volatile("s_waitcnt vmcnt(0) lgkmcnt(0)" ::: "memory"); __builtin_amdgcn_s_barrier(); asm volatile("" ::: "memory"); } while (0)

template <int MODE> struct EpiX {
    static constexpr bool PERM = false, AFTER_DRAIN = true;
    const float* xold; float* xnew; bf16* xb; float* ssq_out; const float* ssq_in; const bf16* pp;
    __device__ __forceinline__ void fused(pg8::f32x4 (&acc)[2][2][4][2], const pg8::Unit& u, int wr, int wc, int fr, int fq, PG8_LAS unsigned char* lds, int wid, int lane) const {
        LAS float* P = (LAS float*)lds;
        const int col0 = u.pn * 256 + wc * 32 + 4 * fq;
#pragma unroll
        for (int ai = 0; ai < 2; ++ai)
#pragma unroll
            for (int m = 0; m < 4; ++m) {
                const int r = ai * 128 + wr * 64 + m * 16 + fr, grow = u.pm * 256 + r; const size_t off = (size_t)grow * D + col0;
                float rs = 0.f; if (MODE == 1) rs = row_rstd(ssq_in, grow);
                float sq = 0.f;
#pragma unroll
                for (int bj = 0; bj < 2; ++bj)
#pragma unroll
                    for (int n = 0; n < 2; ++n) {
                        const size_t c = off + bj * 128 + n * 16;
                        f32x4 v = acc[ai][bj][m][n];
                        if (MODE == 1) { const u32x2 w = *(const u32x2*)(pp + c);
                            v[0] = sigmoidf_(rs * v[0]) * bf_lo(w.x); v[1] = sigmoidf_(rs * v[1]) * bf_hi(w.x); v[2] = sigmoidf_(rs * v[2]) * bf_lo(w.y); v[3] = sigmoidf_(rs * v[3]) * bf_hi(w.y); }
                        const f32x4 xo = *(const f32x4*)(xold + c); const f32x4 xn = xo + v;
                        *(f32x4*)(xnew + c) = xn;
                        u32x2 o; o.x = cvt_pk_bf16(xn[0], xn[1]); o.y = cvt_pk_bf16(xn[2], xn[3]); *(u32x2*)(xb + c) = o;
                        sq += (xn[0] * xn[0] + xn[1] * xn[1]) + (xn[2] * xn[2] + xn[3] * xn[3]);
                    }
                sq += swz_xor<16>(sq); sq = xor32_sum(sq);
                if (fq == 0) P[r * 4 + wc] = sq;
            }
        WG_BAR();
        const int tid = wid * 64 + lane;
        if (tid < 256) { const float s = (P[tid * 4 + 0] + P[tid * 4 + 1]) + (P[tid * 4 + 2] + P[tid * 4 + 3]); ssq_out[(size_t)(u.pm * 256 + tid) * 4 + u.pn] = s; }
        WG_BAR();
    }
};

struct EpiPP {
    static constexpr bool PERM = true, AFTER_DRAIN = false;
    bf16* O;
    __device__ __forceinline__ void operator()(const pg8::f32x4 (&acc)[2][2][4][2], const pg8::Unit& u, int wr, int wc, int fr, int fq) const {
        const int row0 = u.pm * 256 + wr * 64 + fr, col0 = u.pn * 256 + wc * 32 + 8 * fq;
#pragma unroll
        for (int ai = 0; ai < 2; ++ai)
#pragma unroll
            for (int m = 0; m < 4; ++m) { bf16* rowp = O + (size_t)(row0 + ai * 128 + m * 16) * D + col0;
#pragma unroll
                for (int bj = 0; bj < 2; ++bj) { const f32x4 v0 = acc[ai][bj][m][0], v1 = acc[ai][bj][m][1];
                    u32x4 w; w.x = cvt_pk_bf16(v0[0], v0[1]); w.y = cvt_pk_bf16(v0[2], v0[3]); w.z = cvt_pk_bf16(v1[0], v1[1]); w.w = cvt_pk_bf16(v1[2], v1[3]);
                    *(u32x4*)(rowp + bj * 128) = w; } }
    }
};

struct EpiKVQ {
    static constexpr bool PERM = true, AFTER_DRAIN = false;
    const float* ssq_in; const float* rope;
    bf16* kvb; bf16* qb; float* gates; int n_kv;
    __device__ __forceinline__ void operator()(const pg8::f32x4 (&acc)[2][2][4][2], const pg8::Unit& u, int wr, int wc, int fr, int fq) const {
        const int pn = u.pn; const int kind = pn < n_kv ? 0 : (pn < n_kv + 4 ? 1 : 2);
        const bool roped = (kind == 1) || (kind == 0 && (pn == 2 || pn == 4));
        const bool rope_wave = roped && ((wc & 1) == 0);
        const float sgn = (fq == 0) ? -1.f : 1.f;
#pragma unroll
        for (int ai = 0; ai < 2; ++ai)
#pragma unroll
            for (int m = 0; m < 4; ++m) {
                const int grow = u.pm * 256 + ai * 128 + wr * 64 + m * 16 + fr;
                const float rs = row_rstd(ssq_in, grow);
                f32x4 cs0 = {1.f, 1.f, 1.f, 1.f}, cs1 = cs0, sn0 = {0.f, 0.f, 0.f, 0.f}, sn1 = sn0;
                if (rope_wave && fq < 2) { const f32x4* rp = (const f32x4*)(rope + (size_t)grow * 16); cs0 = rp[0]; cs1 = rp[1]; sn0 = rp[2]; sn1 = rp[3]; }
#pragma unroll
                for (int bj = 0; bj < 2; ++bj) {
                    f32x4 v0 = acc[ai][bj][m][0] * rs, v1 = acc[ai][bj][m][1] * rs;
                    if (rope_wave) {
                        f32x4 p0, p1;
#pragma unroll
                        for (int e = 0; e < 4; ++e) { p0[e] = swz_xor<16>(v0[e]); p1[e] = swz_xor<16>(v1[e]); }
                        if (fq < 2) { v0 = v0 * cs0 + (p0 * sn0) * sgn; v1 = v1 * cs1 + (p1 * sn1) * sgn; }
                    }
                    const int cl = bj * 128 + wc * 32 + 8 * fq;
                    if (kind == 2) {
                        if (cl < 48) { float* g = gates + (size_t)grow * 48 + cl;
                            f32x4 a, b;
#pragma unroll
                            for (int e = 0; e < 4; ++e) { a[e] = sigmoidf_(v0[e]); b[e] = sigmoidf_(v1[e]); }
                            *(f32x4*)g = a; *(f32x4*)(g + 4) = b; }
                    } else {
                        if (kind == 1) { v0 = v0 * QSCALE; v1 = v1 * QSCALE; }
                        u32x4 w; w.x = cvt_pk_bf16(v0[0], v0[1]); w.y = cvt_pk_bf16(v0[2], v0[3]); w.z = cvt_pk_bf16(v1[0], v1[1]); w.w = cvt_pk_bf16(v1[2], v1[3]);
                        bf16* dst = (kind == 0) ? kvb + (size_t)grow * NKV + pn * 256 + cl : qb + (size_t)grow * D + (pn - n_kv) * 256 + cl;
                        *(u32x4*)dst = w;
                    }
                }
            }
    }
};

struct EpiCMP {
    static constexpr bool PERM = true, AFTER_DRAIN = false;
    const float* bias1;
    bf16* hid;
    __device__ __forceinline__ void operator()(const pg8::f32x4 (&acc)[2][2][4][2], const pg8::Unit& u, int wr, int wc, int fr, int fq) const {
        const int which = u.pn; const int cl = wc * 32 + 8 * fq;
        const f32x4 b0 = *(const f32x4*)(bias1 + which * 128 + cl), b1 = *(const f32x4*)(bias1 + which * 128 + cl + 4);
#pragma unroll
        for (int ai = 0; ai < 2; ++ai)
#pragma unroll
            for (int m = 0; m < 4; ++m) {
                const int row = u.pm * 256 + ai * 128 + wr * 64 + m * 16 + fr;
                f32x4 v0 = acc[ai][0][m][0] + b0, v1 = acc[ai][0][m][1] + b1;
#pragma unroll
                for (int e = 0; e < 4; ++e) {
                    { const float x = v0[e]; const float y = 0.7978845608028654f * (x + 0.044715f * x * x * x); v0[e] = x / (1.0f + __expf(-2.0f * y)); }
                    { const float x = v1[e]; const float y = 0.7978845608028654f * (x + 0.044715f * x * x * x); v1[e] = x / (1.0f + __expf(-2.0f * y)); }
                }
                u32x4 w; w.x = cvt_pk_bf16(v0[0], v0[1]); w.y = cvt_pk_bf16(v0[2], v0[3]); w.z = cvt_pk_bf16(v1[0], v1[1]); w.w = cvt_pk_bf16(v1[2], v1[3]);
                *(u32x4*)(hid + ((size_t)which * 4096 + row) * 128 + cl) = w;
            }
    }
};

struct EpiUP {
    static constexpr bool PERM = true, AFTER_DRAIN = true;
    const float* ssq_in; const float* convw; const float* convb;
    bf16* h;
    __device__ __forceinline__ void fused(pg8::f32x4 (&acc)[2][2][4][2], const pg8::Unit& u, int wr, int wc, int fr, int fq, PG8_LAS unsigned char* lds, int wid, int lane) const {
        LAS bf16* T = (LAS bf16*)lds;
        const int rbase = UPM * u.pm - 2;
#pragma unroll
        for (int ai = 0; ai < 2; ++ai)
#pragma unroll
            for (int m = 0; m < 4; ++m) {
                const int rl = ai * 128 + wr * 64 + m * 16 + fr; int grow = rbase + rl; grow = grow < 0 ? 0 : (grow >= M ? M - 1 : grow);
                const float rs = row_rstd(ssq_in, grow);
#pragma unroll
                for (int bj = 0; bj < 2; ++bj) { const f32x4 v0 = acc[ai][bj][m][0] * rs, v1 = acc[ai][bj][m][1] * rs;
                    u32x4 w; w.x = cvt_pk_bf16(v0[0], v0[1]); w.y = cvt_pk_bf16(v0[2], v0[3]); w.z = cvt_pk_bf16(v1[0], v1[1]); w.w = cvt_pk_bf16(v1[2], v1[3]);
                    *(LAS u32x4*)(T + rl * TPITCH + bj * 128 + wc * 32 + 8 * fq) = w; }
            }
        WG_BAR();
        const int tid = wid * 64 + lane, c8 = tid & 15, rsub = tid >> 4;
        const int hc = u.pn * 128 + c8 * 8;
        float wa[3][8], wg[3][8], ba[8], bg[8];
#pragma unroll
        for (int t = 0; t < 3; ++t) {
            const f32x4 a0 = *(const f32x4*)(convw + t * FF2 + hc), a1 = *(const f32x4*)(convw + t * FF2 + hc + 4);
            const f32x4 g0 = *(const f32x4*)(convw + t * FF2 + FF + hc), g1 = *(const f32x4*)(convw + t * FF2 + FF + hc + 4);
#pragma unroll
            for (int e = 0; e < 4; ++e) { wa[t][e] = a0[e]; wa[t][4 + e] = a1[e]; wg[t][e] = g0[e]; wg[t][4 + e] = g1[e]; }
        }
        { const f32x4 a0 = *(const f32x4*)(convb + hc), a1 = *(const f32x4*)(convb + hc + 4), g0 = *(const f32x4*)(convb + FF + hc), g1 = *(const f32x4*)(convb + FF + hc + 4);
#pragma unroll
          for (int e = 0; e < 4; ++e) { ba[e] = a0[e]; ba[4 + e] = a1[e]; bg[e] = g0[e]; bg[4 + e] = g1[e]; } }
        for (int p = 0; p < 8; ++p) {
            const int rl = p * 32 + rsub; const int grow = rbase + rl;
            if (rl >= 2 && grow < M) {
                const int t = grow & (SEQ - 1);
                const u32x4 z = {0u, 0u, 0u, 0u};
                const u32x4 a2 = *(const LAS u32x4*)(T + rl * TPITCH + c8 * 8), g2 = *(const LAS u32x4*)(T + rl * TPITCH + 128 + c8 * 8);
                u32x4 a1 = *(const LAS u32x4*)(T + (rl - 1) * TPITCH + c8 * 8), g1 = *(const LAS u32x4*)(T + (rl - 1) * TPITCH + 128 + c8 * 8);
                u32x4 a0 = *(const LAS u32x4*)(T + (rl - 2) * TPITCH + c8 * 8), g0 = *(const LAS u32x4*)(T + (rl - 2) * TPITCH + 128 + c8 * 8);
                if (t < 1) { a1 = z; g1 = z; }
                if (t < 2) { a0 = z; g0 = z; }
                float o[8];
#pragma unroll
                for (int e = 0; e < 4; ++e) {
                    const unsigned A0 = a0[e], A1 = a1[e], A2 = a2[e], G0 = g0[e], G1 = g1[e], G2 = g2[e];
                    const float al = ba[2 * e] + wa[0][2 * e] * bf_lo(A0) + wa[1][2 * e] * bf_lo(A1) + wa[2][2 * e] * bf_lo(A2);
                    const float ah = ba[2 * e + 1] + wa[0][2 * e + 1] * bf_hi(A0) + wa[1][2 * e + 1] * bf_hi(A1) + wa[2][2 * e + 1] * bf_hi(A2);
                    const float gl = bg[2 * e] + wg[0][2 * e] * bf_lo(G0) + wg[1][2 * e] * bf_lo(G1) + wg[2][2 * e] * bf_lo(G2);
                    const float gh = bg[2 * e + 1] + wg[0][2 * e + 1] * bf_hi(G0) + wg[1][2 * e + 1] * bf_hi(G1) + wg[2][2 * e + 1] * bf_hi(G2);
                    o[2 * e] = gl * sigmoidf_(gl) * al; o[2 * e + 1] = gh * sigmoidf_(gh) * ah;
                }
                u32x4 w; w.x = cvt_pk_bf16(o[0], o[1]); w.y = cvt_pk_bf16(o[2], o[3]); w.z = cvt_pk_bf16(o[4], o[5]); w.w = cvt_pk_bf16(o[6], o[7]);
                *(u32x4*)(h + (size_t)grow * FF + hc) = w;
            }
        }
        WG_BAR();
    }
};

namespace att {
constexpr int NSLOT = 3, SLOTB = 8192;
constexpr int LDS_K = 0, LDS_V = NSLOT * SLOTB, LDS_WS = 2 * NSLOT * SLOTB, LDS_IMP = LDS_WS + 2048, LDS_TOT = LDS_IMP + 65536, LDS_SEL = LDS_TOT + 16384;
constexpr float NEGF = -1e30f;
typedef const LAS char* lcp;
typedef short v4i16_t __attribute__((ext_vector_type(4)));
__device__ __forceinline__ s16x4 vtr(lcp p) { return __builtin_bit_cast(s16x4, __builtin_amdgcn_ds_read_tr16_b64_v4i16((LAS v4i16_t*)p)); }
__device__ __forceinline__ int crow(int r, int hi) { return (r & 3) + 8 * (r >> 2) + 4 * hi; }

struct Ctx {
    LAS char* lds; int wid, lane, r32, hi, tl;
    bf16x8 qr[4];
    float m, l; f32x16 o[2];
    float inv_l, carry; int hp;
};

__device__ __forceinline__ void load_tile_regs(const bf16* kb, const bf16* vb, int pitch, int tile, int wid, int lane, u32x4& kr, u32x4& vr) {
    kr = *(const u32x4*)(kb + (size_t)(tile * 64 + lane) * pitch + wid * 8);
    vr = *(const u32x4*)(vb + (size_t)(tile * 64 + 16 * (wid & 3) + (lane >> 2)) * pitch + (wid >> 2) * 32 + (lane & 3) * 8);
}
__device__ __forceinline__ void store_tile_lds(LAS char* lds, int slot, int wid, int lane, const u32x4& kr, const u32x4& vr) {
    *(LAS u32x4*)(lds + LDS_K + slot * 8192 + wid * 1024 + lane * 16) = kr;
    *(LAS u32x4*)(lds + LDS_V + slot * 8192 + wid * 1024 + lane * 16) = vr;
}
__device__ __forceinline__ void qkt(f32x16& p0, f32x16& p1, lcp kslot, const bf16x8* qr, int r32, int hi) {
    lcp kb = kslot + hi * 1024 + r32 * 16;
    f32x16 z;
#pragma unroll
    for (int r = 0; r < 16; ++r) z[r] = 0.f;
    p0 = z; p1 = z;
#pragma unroll
    for (int d0 = 0; d0 < 4; ++d0) {
        const bf16x8 b0 = *(const LAS bf16x8*)(kb + d0 * 2048);
        const bf16x8 b1 = *(const LAS bf16x8*)(kb + d0 * 2048 + 512);
        p0 = __builtin_amdgcn_mfma_f32_32x32x16_bf16(b0, qr[d0], p0, 0, 0, 0);
        p1 = __builtin_amdgcn_mfma_f32_32x32x16_bf16(b1, qr[d0], p1, 0, 0, 0);
    }
}
__device__ __forceinline__ bf16x8 pack8(const f32x16& p, int b) {
    u32x4 w; w.x = cvt_pk_bf16(p[b], p[b + 1]); w.y = cvt_pk_bf16(p[b + 2], p[b + 3]); w.z = cvt_pk_bf16(p[b + 4], p[b + 5]); w.w = cvt_pk_bf16(p[b + 6], p[b + 7]);
    return __builtin_bit_cast(bf16x8, w);
}
__device__ __forceinline__ void pv(f32x16* o, lcp vp, const f32x16& p0, const f32x16& p1) {
    const bf16x8 pa0 = pack8(p0, 0), pa1 = pack8(p0, 8), pa2 = pack8(p1, 0), pa3 = pack8(p1, 8);
#pragma unroll
    for (int d0 = 0; d0 < 2; ++d0) {
#pragma unroll
        for (int ks = 0; ks < 4; ++ks) {
            const s16x4 lo = vtr(vp + d0 * 4096 + ks * 1024), hh = vtr(vp + d0 * 4096 + ks * 1024 + 512);
            const bf16x8 vf = {lo[0], lo[1], lo[2], lo[3], hh[0], hh[1], hh[2], hh[3]};
            const bf16x8 pa = ks == 0 ? pa0 : (ks == 1 ? pa1 : (ks == 2 ? pa2 : pa3));
            o[d0] = __builtin_amdgcn_mfma_f32_32x32x16_bf16(pa, vf, o[d0], 0, 0, 0);
        }
    }
}
template <bool ACCUM> __device__ __forceinline__ void scale_rows(Ctx& c, f32x16* dst, const f32x16* src, float f) {
    LAS float* wsf = (LAS float*)(c.lds + LDS_WS) + c.wid * 64;
    if (c.hi == 0) wsf[c.r32] = f;
    asm volatile("s_waitcnt lgkmcnt(0)" ::: "memory");
#pragma unroll
    for (int r = 0; r < 16; ++r) { const float fr_ = wsf[crow(r, c.hi)];
        if (ACCUM) { dst[0][r] += src[0][r] * fr_; dst[1][r] += src[1][r] * fr_; } else { dst[0][r] = src[0][r] * fr_; dst[1][r] = src[1][r] * fr_; } }
    asm volatile("s_waitcnt lgkmcnt(0)" ::: "memory");
}

template <int EM> __device__ __forceinline__ void emit(Ctx& c, float f, bf16* ob) {
    LAS float* wsf = (LAS float*)(c.lds + LDS_WS) + c.wid * 64;
    LAS float* outb = (LAS float*)(c.lds + LDS_IMP) + c.wid * 2048 + c.lane;
    if (c.hi == 0) wsf[c.r32] = f;
    asm volatile("s_waitcnt lgkmcnt(0)" ::: "memory");
#pragma unroll
    for (int r = 0; r < 16; ++r) { const float fr_ = wsf[crow(r, c.hi)];
#pragma unroll
        for (int d0 = 0; d0 < 2; ++d0) { float v = c.o[d0][r] * fr_; const int idx = d0 * 16 + r;
            if (EM == 0) outb[idx * 64] = v;
            else if (EM == 1) outb[idx * 64] += v;
            else { v += outb[idx * 64]; ob[(size_t)crow(r, c.hi) * D + 32 * d0] = (bf16)(cvt_pk_bf16(v, 0.f) & 0xffffu); } } }
    asm volatile("s_waitcnt lgkmcnt(0)" ::: "memory");
}

template <int MODE> __device__ __forceinline__ void tile_step(Ctx& c, int slot, int klo, int khi, int ct) {
    f32x16 p0, p1;
    qkt(p0, p1, (lcp)(c.lds + LDS_K + slot * 8192), c.qr, c.r32, c.hi);
    const int lo_ = klo - 4 * c.hi, hi_ = khi - 4 * c.hi;
    float rm = NEGF;
#pragma unroll
    for (int r = 0; r < 16; ++r) { const int kk = (r & 3) + 8 * (r >> 2);
        const bool v0 = (kk >= lo_) && (kk <= hi_), v1 = (kk + 32 >= lo_) && (kk + 32 <= hi_);
        p0[r] = v0 ? p0[r] : NEGF; p1[r] = v1 ? p1[r] : NEGF;
        rm = fmaxf(rm, fmaxf(p0[r], p1[r])); }
    rm = xor32_max(rm);
    if (MODE == 1) {
        const float mf = c.m, il = c.inv_l;
#pragma unroll
        for (int r = 0; r < 16; ++r) { p0[r] = (p0[r] > 0.5f * NEGF) ? __builtin_amdgcn_exp2f(p0[r] - mf) * il : 0.f; p1[r] = (p1[r] > 0.5f * NEGF) ? __builtin_amdgcn_exp2f(p1[r] - mf) * il : 0.f; }
        LAS float* imp = (LAS float*)(c.lds + LDS_IMP) + (c.hp * 64 + c.tl) * 64 + 16 * ct + c.hi;
#pragma unroll
        for (int h2 = 0; h2 < 2; ++h2) {
            const f32x16& p = h2 ? p1 : p0;
            float Y[4];
#pragma unroll
            for (int k = 0; k < 4; ++k) Y[k] = xor32_other(p[4 * k + 3], c.hi);
#pragma unroll
            for (int k = 0; k < 4; ++k) {
                const float g4 = (p[4 * k] + p[4 * k + 1]) + (p[4 * k + 2] + p[4 * k + 3]);
                const float prev = c.hi ? Y[k] : (k == 0 ? c.carry : Y[k - 1]);
                imp[8 * h2 + 2 * k] = g4 + prev;
            }
            c.carry = Y[3];
        }
        pv(c.o, (lcp)(c.lds + LDS_V + slot * 8192) + ((c.lane >> 4) & 1) * 32 + (c.lane & 3) * 8 + (4 * c.hi + ((c.lane & 15) >> 2)) * 64, p0, p1);
    } else {
        const float mn = fmaxf(c.m, rm);
        const float alpha = __builtin_amdgcn_exp2f(c.m - mn);
        float s = 0.f;
#pragma unroll
        for (int r = 0; r < 16; ++r) { p0[r] = (p0[r] > 0.5f * NEGF) ? __builtin_amdgcn_exp2f(p0[r] - mn) : 0.f; p1[r] = (p1[r] > 0.5f * NEGF) ? __builtin_amdgcn_exp2f(p1[r] - mn) : 0.f; s += p0[r] + p1[r]; }
        c.l = c.l * alpha + s; c.m = mn;
        if (MODE >= 2) {
            if (__any(alpha != 1.0f)) scale_rows<false>(c, c.o, c.o, alpha);
            pv(c.o, (lcp)(c.lds + LDS_V + slot * 8192) + ((c.lane >> 4) & 1) * 32 + (c.lane & 3) * 8 + (4 * c.hi + ((c.lane & 15) >> 2)) * 64, p0, p1);
        }
    }
}


#define SBAR() __builtin_amdgcn_sched_barrier(0)
#define WAIT_BAR(N) asm volatile("s_waitcnt vmcnt(" #N ") lgkmcnt(0)\n\ts_barrier" ::: "memory")
__device__ __forceinline__ void glds16(const void* gsrc, unsigned lds_dst) { unsigned keep;
    asm volatile("s_mov_b32 %0, m0\n\ts_mov_b32 m0, %2\n\ts_nop 0\n\tglobal_load_lds_dwordx4 %1, off\n\ts_mov_b32 m0, %0" : "=&s"(keep) : "v"(gsrc), "s"(lds_dst) : "memory"); }
typedef float f32x2_t __attribute__((ext_vector_type(2))); typedef __bf16 bf16x2_t __attribute__((ext_vector_type(2)));
__device__ __forceinline__ unsigned cvtpk_s(float lo, float hi) { f32x2_t v = {lo, hi}; bf16x2_t b = __builtin_convertvector(v, bf16x2_t); return __builtin_bit_cast(unsigned, b); }
__device__ __forceinline__ void kload8(bf16x8* kf, lcp kp) {
    kf[0] = *(const LAS bf16x8*)(kp);        kf[1] = *(const LAS bf16x8*)(kp + 512);
    kf[2] = *(const LAS bf16x8*)(kp + 2048); kf[3] = *(const LAS bf16x8*)(kp + 2560);
    kf[4] = *(const LAS bf16x8*)(kp + 4096); kf[5] = *(const LAS bf16x8*)(kp + 4608);
    kf[6] = *(const LAS bf16x8*)(kp + 6144); kf[7] = *(const LAS bf16x8*)(kp + 6656);
}
__device__ __forceinline__ void kload2(bf16x8* kf, lcp kp, int j) { kf[2 * j] = *(const LAS bf16x8*)(kp + j * 2048); kf[2 * j + 1] = *(const LAS bf16x8*)(kp + j * 2048 + 512); }
__device__ __forceinline__ void imask(f32x16& p0, f32x16& p1, int klo, int khi, int hi) {
    const int lo_ = klo - 4 * hi, hi_ = khi - 4 * hi; float ng = NEGF; asm volatile("" : "+v"(ng));
#pragma unroll
    for (int r = 0; r < 16; ++r) { const int kk = (r & 3) + 8 * (r >> 2);
        if (!((kk >= lo_) && (kk <= hi_))) p0[r] = ng;
        if (!((kk + 32 >= lo_) && (kk + 32 <= hi_))) p1[r] = ng; }
}
template <int BR, int THRL> __device__ __forceinline__ void stream(Ctx& c, const bf16* kb0, const bf16* vb0, const int n0, const int NT, const int cur, const unsigned sel_lo, const unsigned sel_hi) {
    const int lane = c.lane, r32 = c.r32, hi = c.hi, wid = c.wid;
    const unsigned lds0 = (unsigned)(uintptr_t)c.lds;
    LAS float* wsf = (LAS float*)(c.lds + LDS_WS) + wid * 64;
    const bf16* ksrc = kb0 + (long)lane * NKV + wid * 8;
    const bf16* vsrc = vb0 + (long)(16 * (wid & 3) + (lane >> 2)) * NKV + (wid >> 2) * 32 + (lane & 3) * 8;
    const unsigned kdst = lds0 + LDS_K + wid * 1024, vdst = lds0 + LDS_V + wid * 1024;
#define TCL(t) ((t) < NT ? (t) : NT - 1)
#define DMA_K(t, slot) glds16(ksrc + (long)TCL(t) * 64 * NKV, (unsigned)__builtin_amdgcn_readfirstlane(kdst + (slot)))
#define DMA_V(t, slot) glds16(vsrc + (long)TCL(t) * 64 * NKV, (unsigned)__builtin_amdgcn_readfirstlane(vdst + (slot)))
    const lcp shm3 = (lcp)c.lds; const lcp kp0 = shm3 + LDS_K + hi * 1024 + r32 * 16; const lcp vp0 = shm3 + LDS_V + ((lane >> 4) & 1) * 32 + (lane & 3) * 8 + (4 * hi + ((lane & 15) >> 2)) * 64;
    bf16x8 kf[8];
    float mhat = 0.f, l_reg = 0.f; bool resc = false; asm volatile("" : "+v"(mhat));
    f32x16 pA0, pA1, pB0, pB1;
    int sl_prev = 0, sl_cur = 0, sl_next = SLOTB;
#define ROT() do { sl_prev = sl_cur; sl_cur = sl_next; sl_next = (sl_next == (NSLOT - 1) * SLOTB) ? 0 : sl_next + SLOTB; } while (0)
#define SELBIT(n) (BR == 0 ? ((((n) < 32) ? (sel_lo >> (n)) : (sel_hi >> ((n) - 32))) & 1u) : 1u)
#define SETCIN(t) f32x16 cin; { const int n_ = n0 + (t); float ng_ = NEGF; asm volatile("" : "+v"(ng_)); const float cv_ = SELBIT(n_) ? -mhat : ng_; cin = (f32x16){cv_, cv_, cv_, cv_, cv_, cv_, cv_, cv_, cv_, cv_, cv_, cv_, cv_, cv_, cv_, cv_}; asm volatile("" : "+v"(cin)); }
#define CMASK(P0, P1, t) do { const int n_ = n0 + (t); if (n_ == cur) imask(P0, P1, 0, c.tl, hi); else if (BR == 1 && n_ == cur - 8) imask(P0, P1, c.tl + 1, 63, hi); } while (0)
#define RESC() do { if (resc) { asm volatile("s_waitcnt lgkmcnt(0)" ::: "memory"); \
      _Pragma("unroll") for (int d_ = 0; d_ < 2; ++d_) _Pragma("unroll") for (int r = 0; r < 16; ++r) c.o[d_][r] *= wsf[crow(r, hi)]; } } while (0)
    DMA_K(0, 0); DMA_V(0, 0); DMA_K(1, SLOTB); DMA_K(2, 2 * SLOTB);
    WAIT_BAR(3);
    {
        SETCIN(0)
        lcp kb = kp0;
#pragma unroll
        for (int d0 = 0; d0 < 4; ++d0) {
            const bf16x8 b0 = *(const LAS bf16x8*)(kb + d0 * 2048), b1 = *(const LAS bf16x8*)(kb + d0 * 2048 + 512);
            if (d0 == 0) { pA0 = __builtin_amdgcn_mfma_f32_32x32x16_bf16(b0, c.qr[0], cin, 0, 0, 0); pA1 = __builtin_amdgcn_mfma_f32_32x32x16_bf16(b1, c.qr[0], cin, 0, 0, 0); }
            else { pA0 = __builtin_amdgcn_mfma_f32_32x32x16_bf16(b0, c.qr[d0], pA0, 0, 0, 0); pA1 = __builtin_amdgcn_mfma_f32_32x32x16_bf16(b1, c.qr[d0], pA1, 0, 0, 0); }
        }
    }
    CMASK(pA0, pA1, 0);
    {
        float rm = NEGF;
#pragma unroll
        for (int r = 0; r < 16; ++r) rm = fmaxf(rm, fmaxf(pA0[r], pA1[r]));
        rm = xor32_max(rm);
        const float dl = rm > -1e29f ? rm : 0.f; mhat = dl;
#pragma unroll
        for (int r = 0; r < 16; ++r) { pA0[r] = __builtin_amdgcn_exp2f(pA0[r] - dl); pA1[r] = __builtin_amdgcn_exp2f(pA1[r] - dl); }
    }
    WAIT_BAR(0);
    DMA_K(3, 0); DMA_V(1, SLOTB);
    ROT();
    kload8(kf, kp0 + sl_cur);
    WAIT_BAR(2);
    s16x4 vlo[8], vhi[8]; u32x4 pw0, pw1, pw2, pw3;
#define PKW(P, B) cvtpk_s(P[B], P[B + 1])
#define PAF(k) __builtin_bit_cast(bf16x8, pw##k)
#define VFR(i) (bf16x8){vlo[i][0], vlo[i][1], vlo[i][2], vlo[i][3], vhi[i][0], vhi[i][1], vhi[i][2], vhi[i][3]}
#define PIN(x) asm volatile("" : "+v"(x))
#define MX3(a, b, c_) __builtin_fmaxf(__builtin_fmaxf((a), (b)), (c_))
#define GAPA(MF, A0, A1, A2, A3, W0, W1, PW) do { MF; sacc += A0; sacc += A1; sacc += A2; sacc += A3; PIN(sacc); W0; W1; PIN(PW); SBAR(); } while (0)
#define EX(v) __builtin_amdgcn_exp2f(v)
#define GAPB(MF, X, B) do { MF; X[B] = EX(X[B]); X[B + 1] = EX(X[B + 1]); X[B + 2] = EX(X[B + 2]); X[B + 3] = EX(X[B + 3]); PIN(X); SBAR(); } while (0)
#define VRD(i) do { vlo[i] = vtr(vp_ + (((i) >> 2) * 4096 + ((i) & 3) * 1024)); vhi[i] = vtr(vp_ + (((i) >> 2) * 4096 + ((i) & 3) * 1024 + 512)); } while (0)
#define KRD(j) do { kload2(kf, kp0 + sl_next, j); SBAR(); } while (0)
#define MFQ(kfi, qi, CI) __builtin_amdgcn_mfma_f32_32x32x16_bf16(kf[kfi], c.qr[qi], CI, 0, 0, 0)
#define MFP(k, vi, oi) c.o[oi] = __builtin_amdgcn_mfma_f32_32x32x16_bf16(PAF(k), VFR(vi), c.o[oi], 0, 0, 0)
#define STEP(C0, C1, P0, P1, t) do { SETCIN(t) SBAR(); \
    const lcp vp_ = vp0 + sl_prev; \
    VRD(0); SBAR(); float sacc = (P0[0] + P0[1]); \
    GAPA(C0 = MFQ(0, 0, cin), P0[2], P0[3], P0[4], P0[5],     pw0[0] = PKW(P0, 0),  pw0[1] = PKW(P0, 2),  pw0); \
    VRD(4); SBAR(); GAPA(C1 = MFQ(1, 0, cin), P0[6], P0[7], P0[8], P0[9],     pw0[2] = PKW(P0, 4),  pw0[3] = PKW(P0, 6),  pw0); \
    VRD(1); SBAR(); GAPA(C0 = MFQ(2, 1, C0),  P0[10], P0[11], P0[12], P0[13], pw1[0] = PKW(P0, 8),  pw1[1] = PKW(P0, 10), pw1); \
    VRD(5); SBAR(); GAPA(C1 = MFQ(3, 1, C1),  P0[14], P0[15], P1[0], P1[1],   pw1[2] = PKW(P0, 12), pw1[3] = PKW(P0, 14), pw1); \
    VRD(2); SBAR(); GAPA(C0 = MFQ(4, 2, C0),  P1[2], P1[3], P1[4], P1[5],     pw2[0] = PKW(P1, 0),  pw2[1] = PKW(P1, 2),  pw2); \
    VRD(6); SBAR(); GAPA(C1 = MFQ(5, 2, C1),  P1[6], P1[7], P1[8], P1[9],     pw2[2] = PKW(P1, 4),  pw2[3] = PKW(P1, 6),  pw2); \
    VRD(3); SBAR(); GAPA(C0 = MFQ(6, 3, C0),  P1[10], P1[11], P1[12], P1[13], pw3[0] = PKW(P1, 8),  pw3[1] = PKW(P1, 10), pw3); \
    VRD(7); SBAR(); GAPA(C1 = MFQ(7, 3, C1),  P1[14], P1[15], 0.f, 0.f,       pw3[2] = PKW(P1, 12), pw3[3] = PKW(P1, 14), pw3); \
    l_reg += sacc; \
    DMA_K((t) + 3, sl_cur); DMA_V((t) + 1, sl_next); \
    CMASK(C0, C1, t); \
    { float a = MX3(C0[0], C0[1], C1[0]), b = MX3(C0[2], C0[3], C1[1]); a = MX3(a, C1[2], C1[3]); \
      _Pragma("unroll") for (int r = 4; r < 16; r += 4) { a = MX3(a, C0[r], C0[r + 1]); b = MX3(b, C0[r + 2], C0[r + 3]); a = MX3(a, C1[r], C1[r + 1]); b = MX3(b, C1[r + 2], C1[r + 3]); } \
      float rm = xor32_max(__builtin_fmaxf(a, b)); \
      resc = false; \
      if (__builtin_expect(__any(rm > (float)THRL), 0)) { const float dl = __builtin_fmaxf(rm, 0.f); mhat += dl; \
        _Pragma("unroll") for (int r = 0; r < 16; ++r) { C0[r] -= dl; C1[r] -= dl; } \
        const float f = __builtin_amdgcn_exp2f(-dl); l_reg *= f; if (hi == 0) wsf[r32] = f; resc = true; } } \
    SBAR(); \
    GAPB(MFP(0, 0, 0), C0, 0); \
    GAPB(MFP(0, 4, 1), C0, 4); \
    KRD(0); GAPB(MFP(1, 1, 0), C0, 8); \
    KRD(1); GAPB(MFP(1, 5, 1), C0, 12); \
    KRD(2); GAPB(MFP(2, 2, 0), C1, 0); \
    KRD(3); GAPB(MFP(2, 6, 1), C1, 4); \
    GAPB(MFP(3, 3, 0), C1, 8); \
    GAPB(MFP(3, 7, 1), C1, 12); \
    } while (0)
    int t = 1;
    for (; t + 1 < NT; t += 2) {
        STEP(pB0, pB1, pA0, pA1, t);     WAIT_BAR(2); RESC(); ROT();
        STEP(pA0, pA1, pB0, pB1, t + 1); WAIT_BAR(2); RESC(); ROT();
    }
    if (t < NT) {
        STEP(pB0, pB1, pA0, pA1, t);     WAIT_BAR(2); RESC(); ROT();
        { float sacc = 0.f;
#pragma unroll
          for (int r = 0; r < 16; ++r) sacc += pB0[r] + pB1[r];
          l_reg += sacc; pv(c.o, vp0 + sl_prev, pB0, pB1); }
    } else {
        { float sacc = 0.f;
#pragma unroll
          for (int r = 0; r < 16; ++r) sacc += pA0[r] + pA1[r];
          l_reg += sacc; pv(c.o, vp0 + sl_prev, pA0, pA1); }
    }
    c.l = l_reg;
    asm volatile("s_waitcnt vmcnt(0) lgkmcnt(0)\n\ts_barrier" ::: "memory");
#undef TCL
#undef DMA_K
#undef DMA_V
#undef ROT
#undef SELBIT
#undef SETCIN
#undef CMASK
#undef RESC
#undef PKW
#undef PAF
#undef VFR
#undef PIN
#undef MX3
#undef GAPA
#undef EX
#undef GAPB
#undef VRD
#undef KRD
#undef MFQ
#undef MFP
#undef STEP
}

struct MaskP { int cmaxq; unsigned sel_lo, sel_hi; int cur; };
template <int MODE> __device__ __forceinline__ void tile_mask(const Ctx& c, const MaskP& mp, int tile, int& klo, int& khi) {
    if (MODE <= 1) { klo = 0; khi = mp.cmaxq - 64 * tile; }
    else if (MODE == 2) { const unsigned bit = tile < 32 ? (mp.sel_lo >> tile) & 1u : (mp.sel_hi >> (tile - 32)) & 1u;
        klo = bit ? 0 : 64; khi = (tile == mp.cur) ? c.tl : 63; }
    else { if (tile == mp.cur) { klo = 0; khi = c.tl; } else if (tile == mp.cur - 8) { klo = c.tl + 1; khi = 63; } else { klo = 0; khi = 63; } }
}
template <int MODE> __device__ __forceinline__ void run_branch(Ctx& c, const MaskP& mp, const bf16* kb, const bf16* vb, int pitch, int tile0, int ntiles) {
    u32x4 kr, vr;
    load_tile_regs(kb, vb, pitch, tile0, c.wid, c.lane, kr, vr);
    store_tile_lds(c.lds, 0, c.wid, c.lane, kr, vr);
    __syncthreads();
    for (int i = 0; i < ntiles; ++i) {
        const bool more = (i + 1 < ntiles);
        if (more) load_tile_regs(kb, vb, pitch, tile0 + i + 1, c.wid, c.lane, kr, vr);
        int klo, khi; tile_mask<MODE>(c, mp, tile0 + i, klo, khi);
        tile_step<MODE>(c, i & 1, klo, khi, tile0 + i);
        if (more) store_tile_lds(c.lds, (i + 1) & 1, c.wid, c.lane, kr, vr);
        __syncthreads();
    }
}

struct Tensors { const bf16* qb; const bf16* kvb; const bf16* kc; const bf16* vc; const float* gates; bf16* ob; };

__device__ __forceinline__ void unit(const Tensors& T, int b, int g, int qb, LAS char* lds, const int tid) {
    Ctx c; c.lds = lds; c.lane = tid & 63; c.wid = __builtin_amdgcn_readfirstlane(tid >> 6); c.r32 = c.lane & 31; c.hi = c.lane >> 5;
    c.hp = c.wid >> 1; const int qh = c.wid & 1; c.tl = 32 * qh + c.r32;
    const int head = 4 * g + c.hp, s = qb * 64, t = s + c.tl; const size_t rowg = (size_t)b * SEQ + t;
#pragma unroll
    for (int d0 = 0; d0 < 4; ++d0) c.qr[d0] = *(const bf16x8*)(T.qb + rowg * D + head * 64 + d0 * 16 + c.hi * 8);
    const float g0 = T.gates[rowg * 48 + head * 3 + 0], g1 = T.gates[rowg * 48 + head * 3 + 1], g2 = T.gates[rowg * 48 + head * 3 + 2];
    MaskP mp; mp.cur = qb; mp.cmaxq = (t >= 31) ? ((t - 31) >> 4) : -1; mp.sel_lo = 0u; mp.sel_hi = 0u;
    const int nct = ((4 * qb + 2) >> 6) + 1;
    const int bg = b * 4 + g;
    const bf16* kcb = T.kc + (size_t)bg * 256 * 64; const bf16* vcb = T.vc + (size_t)bg * 256 * 64;
    const bf16* kvrow = T.kvb + (size_t)b * SEQ * NKV + g * 64;
#pragma unroll
    for (int r = 0; r < 16; ++r) { c.o[0][r] = 0.f; c.o[1][r] = 0.f; }
    c.m = NEGF; c.l = 0.f; c.inv_l = 0.f; c.carry = 0.f;
    run_branch<0>(c, mp, kcb, vcb, 64, 0, nct);
    { const float lt = xor32_sum(c.l); c.inv_l = lt > 0.f ? 1.0f / lt : 0.f; }
    run_branch<1>(c, mp, kcb, vcb, 64, 0, nct);
    {
        LAS float* imp = (LAS float*)(lds + LDS_IMP); LAS float* tot = (LAS float*)(lds + LDS_TOT); LAS unsigned* selw = (LAS unsigned*)(lds + LDS_SEL);
        const int cur = qb;
        for (int idx = tid; idx < 4096; idx += 512) { const int n = idx & 63;
            float v = 0.f; if (n <= cur) v = ((imp[idx] + imp[4096 + idx]) + imp[8192 + idx]) + imp[12288 + idx];
            tot[idx] = v; }
        __syncthreads();
        const int q = tid >> 3, sub = tid & 7; const int nf = cur >= 2 ? 3 : cur + 1; const int Kn = 16 - nf;
        unsigned bits = 0u;
        for (int i = 0; i < 8; ++i) { const int n = sub * 8 + i; bool sb;
            if (n > cur) sb = false; else if (n == 0 || n >= cur - 1) sb = true;
            else { const float v = tot[q * 64 + n]; int rank = 0;
                for (int n2 = 1; n2 <= cur - 2; ++n2) { const float v2 = tot[q * 64 + n2]; rank += ((v2 > v) || (v2 == v && n2 < n)) ? 1 : 0; }
                sb = rank < Kn; }
            bits |= (sb ? 1u : 0u) << i; }
        unsigned lo32 = sub < 4 ? bits << (8 * sub) : 0u, hi32 = sub >= 4 ? bits << (8 * (sub - 4)) : 0u;
        lo32 |= swz_xor_u<1>(lo32); hi32 |= swz_xor_u<1>(hi32); lo32 |= swz_xor_u<2>(lo32); hi32 |= swz_xor_u<2>(hi32); lo32 |= swz_xor_u<4>(lo32); hi32 |= swz_xor_u<4>(hi32);
        if (sub == 0) { selw[q * 2] = lo32; selw[q * 2 + 1] = hi32; }
        __syncthreads();
        mp.sel_lo = selw[c.tl * 2]; mp.sel_hi = selw[c.tl * 2 + 1];
    }
    bf16* ob = T.ob + ((size_t)b * SEQ + s + 32 * qh) * D + head * 64 + c.r32;
    emit<0>(c, g0, ob);
#pragma unroll
    for (int r = 0; r < 16; ++r) { c.o[0][r] = 0.f; c.o[1][r] = 0.f; }
    c.m = NEGF; c.l = 0.f;
    stream<0, 8>(c, kvrow + 512, kvrow + 768, 0, qb + 1, qb, mp.sel_lo, mp.sel_hi);
    { const float lt = xor32_sum(c.l); emit<1>(c, lt > 0.f ? g1 / lt : 0.f, ob); }
#pragma unroll
    for (int r = 0; r < 16; ++r) { c.o[0][r] = 0.f; c.o[1][r] = 0.f; }
    c.m = NEGF; c.l = 0.f;
    { const int w0 = qb >= 8 ? qb - 8 : 0; stream<1, 8>(c, kvrow + 1024 + (size_t)w0 * 64 * NKV, kvrow + 1280 + (size_t)w0 * 64 * NKV, w0, qb - w0 + 1, qb, 0u, 0u); }
    { const float lt = xor32_sum(c.l); emit<2>(c, lt > 0.f ? g2 / lt : 0.f, ob); }
    __syncthreads();
}
}

constexpr size_t MiB = 1u << 20, KiB = 1u << 10;
constexpr size_t WS_CTL = 0, CTL_ZERO_BYTES = 1 * MiB;
constexpr size_t WS_SSQ0 = 1 * MiB, WS_SSQ1 = 1 * MiB + 512 * KiB;
constexpr size_t WS_ROPE = 2 * MiB;
constexpr size_t WS_ROPEC = 3 * MiB;
constexpr size_t WS_CB1 = 3 * MiB + 128 * KiB;
constexpr size_t WS_GATES = 4 * MiB;
constexpr size_t WS_KC = 7 * MiB, WS_VC = 7 * MiB + 512 * KiB;
constexpr size_t WS_HID = 8 * MiB;
constexpr size_t WS_WUP = 16 * MiB;
constexpr size_t WS_WDN = 60 * MiB;
constexpr size_t WS_WG = 82 * MiB;
constexpr size_t WS_WPP = 90 * MiB;
constexpr size_t WS_WPOOL = 92 * MiB;
constexpr size_t WS_WKVQ2 = 93 * MiB;
constexpr size_t WS_WQ3 = 99 * MiB;
constexpr size_t WS_WOUT = 102 * MiB;
constexpr size_t WS_WC1 = 106 * MiB;
constexpr size_t WS_PB = 108 * MiB;
constexpr size_t WS_PP = 140 * MiB;
constexpr size_t WS_XB = 173 * MiB;
constexpr size_t WS_KVB = 206 * MiB;
constexpr size_t WS_H = 255 * MiB;
constexpr size_t WS_QO = WS_H;
constexpr size_t WS_UPOOL = WS_H;
constexpr size_t WS_XBG = WS_H + 32 * MiB;
constexpr size_t WS_END = 343 * MiB;
constexpr int CW_BAR = 4096;

constexpr int RING_BYTES = 131072;
constexpr int LDSCTL_OFF = 139264, MISC_OFF = LDSCTL_OFF + 320;
constexpr int LDS_BYTES = LDSCTL_OFF + 1024;
constexpr int NWAVES = 8;

typedef GAS unsigned gu32;
#define RLX_AGENT __ATOMIC_RELAXED, __HIP_MEMORY_SCOPE_AGENT
#define LDS_WAIT() asm volatile("s_waitcnt lgkmcnt(0)" ::: "memory")
__device__ __forceinline__ unsigned f2bf(float f) { unsigned u = __builtin_bit_cast(unsigned, f); return (u + 0x7fffu + ((u >> 16) & 1u)) >> 16; }
__device__ __forceinline__ unsigned pk2(float lo, float hi) { return f2bf(lo) | (f2bf(hi) << 16); }
__device__ __forceinline__ float wave_sum(float v) {
    v += swz_xor<1>(v); v += swz_xor<2>(v); v += swz_xor<4>(v); v += swz_xor<8>(v); v += swz_xor<16>(v);
    return xor32_sum(v);
}

#define XB_TMO      128
#define XB_XCNT(j)  (256  + 64 * (j))
#define XB_XSUB(j)  (1280 + 64 * (j))
#define XB_XGEN(j)  (2304 + 64 * (j))
#define XB_TOP      3328
#define XB_TOPGEN   3392
#define XCD_BAR_WORDS 3456
#define XB_SPIN_CAP (1u << 18)

__device__ __forceinline__ unsigned xb_ld(unsigned* p)              { return __hip_atomic_load(p, __ATOMIC_RELAXED, __HIP_MEMORY_SCOPE_AGENT); }
__device__ __forceinline__ unsigned xb_add(unsigned* p, unsigned v) { return __hip_atomic_fetch_add(p, v, __ATOMIC_RELAXED, __HIP_MEMORY_SCOPE_AGENT); }
__device__ __forceinline__ unsigned xb_xcc_id() { return (unsigned)__builtin_amdgcn_s_getreg((3 << 11) | 20) & 0xFu; }
#define XB_SPIN(cond, bar) do { unsigned _sp = 0; while (cond) { __builtin_amdgcn_s_sleep(1); \
    if ((++_sp & 255u) == 0u) { if (xb_ld(&(bar)[XB_TMO])) break; if (_sp > XB_SPIN_CAP) { atomicAdd(&(bar)[XB_TMO], 1u); break; } } } } while (0)

struct XcdBarrier {
    unsigned* bar; unsigned x;
    volatile LAS unsigned* st;
};

__device__ __forceinline__ XcdBarrier xcd_barrier_post(unsigned* bar, volatile LAS unsigned* st) {
    XcdBarrier b; b.bar = bar; b.x = xb_xcc_id(); b.st = st;
    if (threadIdx.x == 0) (void)xb_add(&bar[XB_XCNT(b.x)], 1u);
    return b;
}
__device__ __forceinline__ void xcd_barrier_complete(unsigned* bar, unsigned x, unsigned& nloc, unsigned& nx) {
    const unsigned G = gridDim.x * gridDim.y * gridDim.z;
    unsigned sum, cnt, mine, sp = 0u;
    for (;;) {
        sum = 0u; cnt = 0u; mine = 0u;
#pragma unroll
        for (unsigned j = 0; j < 16; ++j) { const unsigned c = xb_ld(&bar[XB_XCNT(j)]); sum += c; cnt += (c > 0u) ? 1u : 0u; mine = (j == x) ? c : mine; }
        if (sum == G) break;
        __builtin_amdgcn_s_sleep(1);
        if ((++sp & 255u) == 0u) { if (xb_ld(&bar[XB_TMO])) break; if (sp > XB_SPIN_CAP) { atomicAdd(&bar[XB_TMO], 1u); break; } }
    }
    nloc = mine > 0u ? mine : 1u; nx = cnt > 0u ? cnt : 1u;
}

__device__ __forceinline__ void xcd_barrier(const XcdBarrier& b) {
    asm volatile("s_waitcnt vmcnt(0)" ::: "memory");
    __syncthreads();
    if (threadIdx.x == 0) {
        unsigned* bar = b.bar;
        __builtin_amdgcn_s_waitcnt(0);
        unsigned nloc = b.st[0], nx = b.st[1];
        if (nloc == 0u) { xcd_barrier_complete(bar, b.x, nloc, nx); b.st[0] = nloc; b.st[1] = nx; }
        const unsigned old = xb_add(&bar[XB_XSUB(b.x)], 1u);
        const unsigned gen = old / nloc;
        if (old + 1u == (gen + 1u) * nloc) {
            __builtin_amdgcn_fence(__ATOMIC_RELEASE, "agent");
            asm volatile("s_waitcnt vmcnt(0)" ::: "memory");
            const unsigned og = xb_add(&bar[XB_TOP], 1u);
            const unsigned tg = og / nx;
            if (og + 1u == (tg + 1u) * nx) xb_add(&bar[XB_TOPGEN], 1u);
            else XB_SPIN(xb_ld(&bar[XB_TOPGEN]) == tg, bar);
            __builtin_amdgcn_fence(__ATOMIC_ACQUIRE, "agent");
            xb_add(&bar[XB_XGEN(b.x)], 1u);
            asm volatile("s_waitcnt vmcnt(0)" ::: "memory");
        } else {
            XB_SPIN(xb_ld(&bar[XB_XGEN(b.x)]) == gen, bar);
            __builtin_amdgcn_fence(__ATOMIC_ACQUIRE, "agent");
            asm volatile("s_waitcnt vmcnt(0)" ::: "memory");
        }
    }
    __syncthreads();
}


struct Args { const void* in[25]; float* out; unsigned char* ws; int ph_lo, ph_hi; };

struct Frame {
    LAS unsigned char* lds;
    int tid, lane, wave, vcu, G;
    unsigned char* ws;
};

__device__ __forceinline__ void transpose_item(const float* W, int N, int k0, int n0, bf16* WT, int ldt, int dst_row0, const float* gk, const float* gn, LAS float* scr, int lane) {
    const int c4 = lane & 7, r8 = lane >> 3, n = n0 + 4 * c4; const bool nv = n < N;
    f32x4 v[8]; float gkk[8];
#pragma unroll
    for (int i = 0; i < 8; ++i) { const int kk = r8 + 8 * i; v[i] = nv ? *(const f32x4*)(W + (size_t)(k0 + kk) * N + n) : (f32x4){0.f, 0.f, 0.f, 0.f}; gkk[i] = gk ? gk[k0 + kk] : 1.0f; }
    f32x4 sn = {1.f, 1.f, 1.f, 1.f}; if (gn && nv) sn = *(const f32x4*)(gn + n);
#pragma unroll
    for (int i = 0; i < 8; ++i) { const int kk = r8 + 8 * i; const f32x4 w = v[i] * gkk[i] * sn; LAS float* d = scr + kk * 33 + 4 * c4; d[0] = w[0]; d[1] = w[1]; d[2] = w[2]; d[3] = w[3]; }
    LDS_WAIT(); asm volatile("" ::: "memory");
    const int c = lane & 7;
#pragma unroll
    for (int j = 0; j < 4; ++j) { const int nn = (lane >> 3) + 8 * j; const LAS float* s = scr + (8 * c) * 33 + nn;
        u32x4 o; o.x = pk2(s[0 * 33], s[1 * 33]); o.y = pk2(s[2 * 33], s[3 * 33]); o.z = pk2(s[4 * 33], s[5 * 33]); o.w = pk2(s[6 * 33], s[7 * 33]);
        *(u32x4*)(WT + (size_t)(dst_row0 + nn) * ldt + k0 + 8 * c) = o; }
    LDS_WAIT(); asm volatile("" ::: "memory");
}
__device__ __forceinline__ void sincos_f(float a, float& cs, float& sn) {
    const float q = rintf(a * 0.636619772f); float r = fmaf(-q, 1.5707963705062866f, a); r = fmaf(-q, -4.37113883e-8f, r);
    const float r2 = r * r;
    const float sp = r * (1.0f + r2 * (-1.666666667e-1f + r2 * (8.333333333e-3f + r2 * (-1.984126984e-4f + r2 * 2.755731922e-6f))));
    const float cp = 1.0f + r2 * (-0.5f + r2 * (4.166666667e-2f + r2 * (-1.388888889e-3f + r2 * 2.480158730e-5f)));
    const int qi = ((int)q) & 3;
    sn = (qi == 0) ? sp : (qi == 1) ? cp : (qi == 2) ? -sp : -cp;
    cs = (qi == 0) ? cp : (qi == 1) ? -sp : (qi == 2) ? -cp : sp;
}
__device__ __forceinline__ float inv_freq(int j) {
    return j == 0 ? 0x1.0p+0f : j == 1 ? 0x1.8d275ep-3f : j == 2 ? 0x1.341190p-5f : j == 3 ? 0x1.ddee9cp-8f : j == 4 ? 0x1.72ba44p-10f : j == 5 ? 0x1.1f91f0p-12f : j == 6 ? 0x1.be2188p-15f : 0x1.5a0f4ep-17f;
}

__device__ __forceinline__ void phase_prologue(Frame& F, const Args& a) {
    const float* x = (const float*)a.in[0]; const float* p = (const float*)a.in[1]; const int* pos = (const int*)a.in[2];
    const float* norm_mix = (const float*)a.in[3]; const float* pool_w = (const float*)a.in[4]; const float* pool_scale = (const float*)a.in[5];
    const float* norm_kv = (const float*)a.in[6]; const float* w_kv = (const float*)a.in[7];
    const float* cmp_pos_k = (const float*)a.in[8]; const float* cmp_pos_v = (const float*)a.in[11]; const float* cmp_w1_k = (const float*)a.in[9]; const float* cmp_w1_v = (const float*)a.in[12];
    const float* w_in = (const float*)a.in[14]; const float* w_out = (const float*)a.in[15];
    const float* norm_ffn = (const float*)a.in[16]; const float* ffn_up = (const float*)a.in[17]; const float* ffn_down = (const float*)a.in[20];
    const float* norm_ple = (const float*)a.in[21]; const float* ple_gate = (const float*)a.in[22]; const float* ple_proj = (const float*)a.in[23];
    unsigned char* ws = F.ws;
    LAS float* scr = (LAS float*)(F.lds + F.wave * 16384);
    const int gw = F.vcu * NWAVES + F.wave, NGW = F.G * NWAVES;
    const int gt = gw * 64 + F.lane, NGT = NGW * 64;
    constexpr int I_UP = 16 * 176, I_DN = 44 * 32, I_G = 16 * 32, I_PP = 4 * 32, I_POOL = 4 * 8, I_KV = 16 * 48, I_IN = 16 * 34, I_OUT = 16 * 32, I_C1 = 32 * 4;
    constexpr int T_UP = 4 * I_UP, T_DN = 4 * I_DN, T_G = 4 * I_G, T_PP = 4 * I_PP, T_POOL = 8 * I_POOL, T_KV = I_KV, T_IN = 2 * I_IN, T_OUT = 2 * I_OUT, T_C1 = 2 * I_C1;
    constexpr int NITEMS = T_UP + T_DN + T_G + T_PP + T_POOL + T_KV + T_IN + T_OUT + T_C1;
    for (int it = gw; it < NITEMS; it += NGW) {
        int r = it;
        if (r < T_UP) { const int l = r / I_UP, q = r % I_UP, kb = q / 176, nb = q % 176, n0 = 32 * nb;
            const int dst = (n0 < FF) ? (n0 / 128) * 256 + (n0 % 128) : ((n0 - FF) / 128) * 256 + 128 + ((n0 - FF) % 128);
            transpose_item(ffn_up + (size_t)l * D * FF2, FF2, 64 * kb, n0, (bf16*)(ws + WS_WUP) + (size_t)l * FF2 * D, D, dst, norm_ffn + l * D, nullptr, scr, F.lane); continue; } r -= T_UP;
        if (r < T_DN) { const int l = r / I_DN, q = r % I_DN, kb = q / 32, nb = q % 32;
            transpose_item(ffn_down + (size_t)l * FF * D, D, 64 * kb, 32 * nb, (bf16*)(ws + WS_WDN) + (size_t)l * D * FF, FF, 32 * nb, nullptr, nullptr, scr, F.lane); continue; } r -= T_DN;
        if (r < T_G) { const int l = r / I_G, q = r % I_G, kb = q / 32, nb = q % 32;
            transpose_item(ple_gate + (size_t)l * D * D, D, 64 * kb, 32 * nb, (bf16*)(ws + WS_WG) + (size_t)l * D * D, D, 32 * nb, norm_ple + l * D, nullptr, scr, F.lane); continue; } r -= T_G;
        if (r < T_PP) { const int l = r / I_PP, q = r % I_PP, kb = q / 32, nb = q % 32;
            transpose_item(ple_proj + (size_t)l * PLE * D, D, 64 * kb, 32 * nb, (bf16*)(ws + WS_WPP) + (size_t)l * D * PLE, PLE, 32 * nb, nullptr, nullptr, scr, F.lane); continue; } r -= T_PP;
        if (r < T_POOL) { const int lg = r / I_POOL, q = r % I_POOL, kb = q / 8, nb = q % 8, l = lg >> 2, gi = lg & 3;
            transpose_item(pool_w + (size_t)lg * 256 * 256, 256, 64 * kb, 32 * nb, (bf16*)(ws + WS_WPOOL) + (size_t)l * D * 256, 256, gi * 256 + 32 * nb, nullptr, pool_scale + l * D + gi * 256, scr, F.lane); continue; } r -= T_POOL;
        if (r < T_KV) { const int kb = r / 48, nb = r % 48;
            transpose_item(w_kv, NKV, 64 * kb, 32 * nb, (bf16*)(ws + WS_WKVQ2), D, 32 * nb, norm_kv, nullptr, scr, F.lane); continue; } r -= T_KV;
        if (r < T_IN) { const int j = r / I_IN, q = r % I_IN, kb = q / 34, nb = q % 34;
            bf16* dstp = j == 0 ? (bf16*)(ws + WS_WKVQ2) + (size_t)NKV * D : (bf16*)(ws + WS_WQ3);
            transpose_item(w_in + (size_t)j * D * NQC, NQC, 64 * kb, 32 * nb, dstp, D, 32 * nb, norm_mix + (2 + j) * D, nullptr, scr, F.lane); continue; } r -= T_IN;
        if (r < T_OUT) { const int j = r / I_OUT, q = r % I_OUT, kb = q / 32, nb = q % 32;
            transpose_item(w_out + (size_t)j * D * D, D, 64 * kb, 32 * nb, (bf16*)(ws + WS_WOUT) + (size_t)j * D * D, D, 32 * nb, nullptr, nullptr, scr, F.lane); continue; } r -= T_OUT;
        { const int wh = r / I_C1, q = r % I_C1, kb = q / 4, nb = q % 4;
            transpose_item(wh ? cmp_w1_v : cmp_w1_k, 128, 64 * kb, 32 * nb, (bf16*)(ws + WS_WC1) + (size_t)wh * 256 * 2048, 2048, 32 * nb, nullptr, nullptr, scr, F.lane); }
    }
    {
        constexpr int Z1 = 192 * D / 8, Z3 = 128 * 2048 / 8;
        for (int i = gt; i < 2 * Z1 + 2 * Z3; i += NGT) {
            u32x4* dst;
            if (i < Z1) dst = (u32x4*)((bf16*)(ws + WS_WKVQ2) + (size_t)2624 * D) + i;
            else if (i < 2 * Z1) dst = (u32x4*)((bf16*)(ws + WS_WQ3) + (size_t)1088 * D) + (i - Z1);
            else if (i < 2 * Z1 + Z3) dst = (u32x4*)((bf16*)(ws + WS_WC1) + (size_t)128 * 2048) + (i - 2 * Z1);
            else dst = (u32x4*)((bf16*)(ws + WS_WC1) + (size_t)256 * 2048 + (size_t)128 * 2048) + (i - 2 * Z1 - Z3);
            unsigned zz = 0u; asm volatile("" : "+v"(zz)); const u32x4 z = {zz, zz, zz, zz};
            *dst = z;
        }
    }
    { const f32x4* src = (const f32x4*)p; u32x4* dst = (u32x4*)(ws + WS_PB); const int n8 = DEPTH * M * PLE / 8;
      for (int i0 = gt; i0 < n8; i0 += 4 * NGT) { f32x4 a0[4], a1[4];
#pragma unroll
          for (int u = 0; u < 4; ++u) { const int i = i0 + u * NGT; if (i < n8) { a0[u] = src[2 * i]; a1[u] = src[2 * i + 1]; } }
#pragma unroll
          for (int u = 0; u < 4; ++u) { const int i = i0 + u * NGT; if (i < n8) { u32x4 o; o.x = pk2(a0[u][0], a0[u][1]); o.y = pk2(a0[u][2], a0[u][3]); o.z = pk2(a1[u][0], a1[u][1]); o.w = pk2(a1[u][2], a1[u][3]); dst[i] = o; } } } }
    { float* rope = (float*)(ws + WS_ROPE);
      for (int i = gt; i < M * 8; i += NGT) { const int row = i >> 3, j = i & 7; const float ang = (float)pos[row] * inv_freq(j); float cs, sn; sincos_f(ang, cs, sn); rope[row * 16 + j] = cs; rope[row * 16 + 8 + j] = sn; }
      float* ropec = (float*)(ws + WS_ROPEC);
      for (int i = gt; i < NBATCH * 256 * 8; i += NGT) { const int j = i & 7, c = (i >> 3) & 255, b = i >> 11; float cs = 1.f, sn = 0.f;
          if (c < 255) { const float ang = (float)pos[b * SEQ + 16 * c + 31] * inv_freq(j); sincos_f(ang, cs, sn); }
          ropec[(b * 256 + c) * 16 + j] = cs; ropec[(b * 256 + c) * 16 + 8 + j] = sn; } }
    { float* cb1 = (float*)(ws + WS_CB1);
      for (int o = gw; o < 256; o += NGW) { const int wh = o >> 7, j = o & 127; float s = 0.f;
          const float* cp_ = wh ? cmp_pos_v : cmp_pos_k; const float* cw_ = wh ? cmp_w1_v : cmp_w1_k;
#pragma unroll 32
          for (int k = F.lane; k < 2048; k += 64) s += cp_[k] * cw_[(size_t)k * 128 + j];
          s = wave_sum(s); if (F.lane == 0) cb1[o] = s; } }
    { float* ssq = (float*)(ws + WS_SSQ0);
      for (int m0 = gw; m0 < M; m0 += 4 * NGW) { f32x4 v[4][4];
#pragma unroll
          for (int u = 0; u < 4; ++u) { const int m = m0 + u * NGW; if (m < M) { const f32x4* xr = (const f32x4*)(x + (size_t)m * D) + F.lane;
#pragma unroll
              for (int j = 0; j < 4; ++j) v[u][j] = xr[64 * j]; } }
#pragma unroll
          for (int u = 0; u < 4; ++u) { const int m = m0 + u * NGW; if (m < M) { float s = 0.f;
#pragma unroll
              for (int j = 0; j < 4; ++j) s += (v[u][j][0] * v[u][j][0] + v[u][j][1] * v[u][j][1]) + (v[u][j][2] * v[u][j][2] + v[u][j][3] * v[u][j][3]);
              s = wave_sum(s); if (F.lane == 0) { f32x4 o = {s, 0.f, 0.f, 0.f}; *(f32x4*)(ssq + (size_t)m * 4) = o; } } } } }
}

__device__ __forceinline__ void phase_poolprep(Frame& F, const float* xsrc, const float* ssq, const float* gmix, bf16* upool) {
    const int gw = F.vcu * NWAVES + F.wave, NGW = F.G * NWAVES;
    for (int task = gw; task < 4 * (M / 32); task += NGW) {
        const int j = task & 3, strip = task >> 2, t0 = strip * 32, bs = t0 & ~(SEQ - 1), W = 2 << j;
        const int col = 256 * j + 4 * F.lane;
        const f32x4 gv = *(const f32x4*)(gmix + col);
        f32x4 ring[16];
#pragma unroll
        for (int k = 0; k < 15; ++k) { const int tp = t0 - 15 + k; f32x4 hv = {0.f, 0.f, 0.f, 0.f};
            if (tp >= bs) { const float rs = row_rstd(ssq, tp); hv = *(const f32x4*)(xsrc + (size_t)tp * D + col) * rs * gv; }
            ring[(k + 1) & 15] = hv; }
#pragma unroll
        for (int i = 0; i < 32; ++i) { const int t = t0 + i; const float rs = row_rstd(ssq, t);
            const f32x4 hv = *(const f32x4*)(xsrc + (size_t)t * D + col) * rs * gv;
            ring[i & 15] = hv;
            f32x4 sum = hv;
#pragma unroll
            for (int k = 1; k < 16; ++k) if (k < W) sum += ring[(i - k) & 15];
            const int cnt = (t - bs + 1) < W ? (t - bs + 1) : W;
            const f32x4 u = sum * (1.0f / (float)cnt) - hv;
            u32x2 o; o.x = cvt_pk_bf16(u[0], u[1]); o.y = cvt_pk_bf16(u[2], u[3]);
            *(u32x2*)(upool + (size_t)t * D + col) = o; }
    }
}

__device__ __forceinline__ void phase_cmp2(Frame& F, const bf16* hid, const float* w2k, const float* w2v, const float* ropec, bf16* kc, bf16* vc) {
    const int gw = F.vcu * NWAVES + F.wave, NGW = F.G * NWAVES;
    LAS float* W2 = (LAS float*)F.lds;
    LAS float* hb = (LAS float*)(F.lds + 65536) + F.wave * 128;
    for (int i = F.tid; i < 2 * 128 * 64 / 4; i += NWAVES * 64) { const f32x4 v = (i < 2048) ? ((const f32x4*)w2k)[i] : ((const f32x4*)w2v)[i - 2048]; *(LAS f32x4*)(W2 + 4 * i) = v; }
    WG_BAR();
    for (int task = gw; task < 2 * 4096; task += NGW) {
        const int wh = task >> 12, row = task & 4095, c = row & 255, bg = row >> 8, b = bg >> 2, d = F.lane;
        const bf16* hr = hid + ((size_t)wh * 4096 + row) * 128;
        hb[d] = __uint_as_float(((unsigned)hr[d]) << 16); hb[64 + d] = __uint_as_float(((unsigned)hr[64 + d]) << 16);
        LDS_WAIT();
        const LAS float* w2 = W2 + wh * 8192 + d;
        float s = 0.f;
#pragma unroll 16
        for (int j = 0; j < 128; ++j) s += hb[j] * w2[j * 64];
        if (wh == 0) { const float partner = swz_xor<8>(s);
            if (d < 16) { const float cs = ropec[(b * 256 + c) * 16 + (d & 7)], sn = ropec[(b * 256 + c) * 16 + 8 + (d & 7)]; s = (d < 8) ? s * cs - partner * sn : s * cs + partner * sn; } }
        if (c == 255) s = 0.f;
        (wh ? vc : kc)[(size_t)row * 64 + d] = (bf16)f2bf(s);
        LDS_WAIT();
    }
    WG_BAR();
}

__device__ __forceinline__ void phase_final(Frame& F, float* x, const float* gfin) {
    const int gw = F.vcu * NWAVES + F.wave, NGW = F.G * NWAVES;
    for (int m = gw; m < M; m += NGW) { f32x4* xr = (f32x4*)(x + (size_t)m * D) + F.lane; f32x4 v[4]; float s = 0.f;
#pragma unroll
        for (int j = 0; j < 4; ++j) { v[j] = xr[64 * j]; s += (v[j][0] * v[j][0] + v[j][1] * v[j][1]) + (v[j][2] * v[j][2] + v[j][3] * v[j][3]); }
        const float rs = rsqrtf(wave_sum(s) * (1.0f / D) + EPS);
#pragma unroll
        for (int j = 0; j < 4; ++j) { const f32x4 gv = *((const f32x4*)gfin + F.lane + 64 * j); xr[64 * j] = v[j] * rs * gv; } }
}

#ifndef MK_CHECK
#define MK_CHECK 0
#endif
#ifndef MK_CHECK_SEL
#define MK_CHECK_SEL 0
#endif
#if MK_CHECK
constexpr int CW_CHK = 2048;
__device__ __forceinline__ float bf2f(bf16 v) { return __uint_as_float(((unsigned)v) << 16); }
__device__ __forceinline__ void chk_add(float* base, int which, float d2, float r2) {
    d2 = wave_sum(d2); r2 = wave_sum(r2);
    if ((threadIdx.x & 63) == 0) { atomicAdd(base + 2 * which, d2); atomicAdd(base + 2 * which + 1, r2); }
}
__device__ __forceinline__ float chk_dot(const float* xrow, float rs, const float* g, const float* W, int pitch, int col) {
    float s = 0.f; for (int k = 0; k < D; ++k) s += xrow[k] * rs * g[k] * W[(size_t)k * pitch + col]; return s;
}
__device__ __forceinline__ void check_proj(const Args& a, unsigned char* ws, int gtid, int ngt) {
    const float* X = a.out; const int* pos = (const int*)a.in[2]; const float* norm_mix2 = (const float*)a.in[3] + 2 * D; const float* norm_kv = (const float*)a.in[6];
    const float* w_kv = (const float*)a.in[7]; const float* w_in = (const float*)a.in[14];
    const bf16* KVB = (const bf16*)(ws + WS_KVB); const bf16* QO = (const bf16*)(ws + WS_QO); const float* GT = (const float*)(ws + WS_GATES);
    float* sums = (float*)(ws + WS_CTL) + CW_CHK;
    const int NS = 48, NC = NKV + NQC;
    float d2[4] = {0.f, 0.f, 0.f, 0.f}, r2[4] = {0.f, 0.f, 0.f, 0.f};
    for (int task = gtid; task < NS * NC; task += ngt) {
        const int i = task / NC, col = task % NC, row = (37 + 653 * i) % M; const float* xr = X + (size_t)row * D;
        float ss = 0.f; for (int k = 0; k < D; ++k) ss += xr[k] * xr[k];
        const float rs = rsqrtf(ss / D + EPS);
        const bool iskv = col < NKV; const int cq = col - NKV;
        const float* g = iskv ? norm_kv : norm_mix2; const float* W = iskv ? w_kv : w_in; const int pitch = iskv ? NKV : NQC; const int wc = iskv ? col : cq;
        float v = chk_dot(xr, rs, g, W, pitch, wc);
        const int d = wc & 63; bool roped = false;
        if (iskv) { const int t6 = col >> 8; roped = (t6 == 2 || t6 == 4) && d < 16; } else roped = (cq < 1024) && d < 16;
        if (roped) { const float v2 = chk_dot(xr, rs, g, W, pitch, d < 8 ? wc + 8 : wc - 8); float cs, sn; sincos_f((float)pos[row] * inv_freq(d & 7), cs, sn); v = d < 8 ? v * cs - v2 * sn : v * cs + v2 * sn; }
        float ref, got; int cat;
        if (iskv) { ref = v; got = bf2f(KVB[(size_t)row * NKV + col]); cat = roped ? 1 : 0; }
        else if (cq < 1024) { ref = v * QSCALE; got = bf2f(QO[(size_t)row * D + cq]); cat = 2; }
        else { ref = 1.0f / (1.0f + __expf(-v)); got = GT[(size_t)row * 48 + (cq - 1024)]; cat = 3; }
        const float df = got - ref;
#pragma unroll
        for (int c = 0; c < 4; ++c) if (cat == c) { d2[c] += df * df; r2[c] += ref * ref; }
    }
#pragma unroll
    for (int c = 0; c < 4; ++c) chk_add(sums, c, d2[c], r2[c]);
}
__device__ __forceinline__ void check_cmp(const Args& a, unsigned char* ws, int gwave, int ngw, int lane) {
    const int* pos = (const int*)a.in[2];
    const bf16* KVB = (const bf16*)(ws + WS_KVB); float* sums = (float*)(ws + WS_CTL) + CW_CHK;
    for (int smp = gwave; smp < 2 * 4 * 5; smp += ngw) {
        const int which = smp & 1, bgi = (smp >> 1) & 3, ci = smp >> 3; const int bg = bgi * 5, b = bg >> 2, g = bg & 3;
        const int c = ci == 0 ? 0 : ci == 1 ? 1 : ci == 2 ? 17 : ci == 3 ? 100 : 254;
        const float* cpos = (const float*)a.in[which ? 11 : 8]; const float* w1 = (const float*)a.in[which ? 12 : 9]; const float* w2 = (const float*)a.in[which ? 13 : 10];
        float h0 = 0.f, h1 = 0.f;
        for (int k = 0; k < 2048; ++k) { const int l = k >> 6, d = k & 63;
            const float z = bf2f(KVB[((size_t)b * SEQ + 16 * c + l) * NKV + which * 256 + g * 64 + d]) + cpos[k];
            h0 += z * w1[(size_t)k * 128 + lane]; h1 += z * w1[(size_t)k * 128 + 64 + lane]; }
        { const float y0 = 0.7978845608028654f * (h0 + 0.044715f * h0 * h0 * h0), y1 = 0.7978845608028654f * (h1 + 0.044715f * h1 * h1 * h1); h0 = h0 / (1.0f + __expf(-2.0f * y0)); h1 = h1 / (1.0f + __expf(-2.0f * y1)); }
        float o = 0.f;
        for (int j = 0; j < 64; ++j) { o += __shfl(h0, j) * w2[j * 64 + lane]; }
        for (int j = 0; j < 64; ++j) { o += __shfl(h1, j) * w2[(64 + j) * 64 + lane]; }
        if (which == 0) { const float partner = __shfl_xor(o, 8);
            if (lane < 16) { float cs, sn; sincos_f((float)pos[b * SEQ + 16 * c + 31] * inv_freq(lane & 7), cs, sn); o = lane < 8 ? o * cs - partner * sn : o * cs + partner * sn; } }
        const float got = bf2f(((const bf16*)(ws + (which ? WS_VC : WS_KC)))[((size_t)bg * 256 + c) * 64 + lane]);
        const float df = got - o; chk_add(sums, 4 + which, df * df, o * o);
    }
}
__device__ __forceinline__ void check_attn(unsigned char* ws, LAS unsigned char* lds, int wave, int gwave, int ngw, int lane) {
    const bf16* QO = (const bf16*)(ws + WS_QO); const bf16* KVB = (const bf16*)(ws + WS_KVB); const bf16* KC = (const bf16*)(ws + WS_KC); const bf16* VC = (const bf16*)(ws + WS_VC);
    const float* GT = (const float*)(ws + WS_GATES); const bf16* OB = (const bf16*)(ws + WS_XB); float* sums = (float*)(ws + WS_CTL) + CW_CHK;
    LAS float* P = (LAS float*)(lds + wave * 8192);
    LAS float* qbuf = P + 1024;
    LAS float* pbuf = qbuf + 64;
    LAS float* sbuf = pbuf + 64;
    for (int smp = gwave; smp < 24 * 8; smp += ngw) {
        const int ti = smp % 24, v8 = smp / 24;
        const int t = ti == 0 ? 0 : ti == 1 ? 5 : ti == 2 ? 30 : ti == 3 ? 31 : ti == 4 ? 47 : ti == 5 ? 63 : ti == 6 ? 64 : ti == 7 ? 100 : ti == 8 ? 511 : ti == 9 ? 512 : ti == 10 ? 513 : ti == 11 ? 1000 : ti == 12 ? 1023 : ti == 13 ? 1024 : ti == 14 ? 1025 : ti == 15 ? 1088 : ti == 16 ? 1500 : ti == 17 ? 2047 : ti == 18 ? 2048 : ti == 19 ? 2500 : ti == 20 ? 3000 : ti == 21 ? 3583 : ti == 22 ? 4000 : 4095;
        const int bg = (v8 * 7 + ti) & 15, b = bg >> 2, g = bg & 3, cur = t >> 6; const size_t rowg = (size_t)b * SEQ + t;
        const int cmax = t >= 31 ? (t - 31) >> 4 : -1;
        for (int hp = 0; hp < 4; ++hp) { const int head = 4 * g + hp;
            qbuf[lane] = bf2f(QO[rowg * D + head * 64 + lane]);
            float s[4]; float mx = -INFINITY;
#pragma unroll
            for (int j = 0; j < 4; ++j) { const int c = lane + 64 * j; s[j] = -INFINITY;
                if (c <= cmax) { float acc = 0.f; for (int d = 0; d < 64; ++d) acc += qbuf[d] * bf2f(KC[((size_t)bg * 256 + c) * 64 + d]); s[j] = acc; }
                mx = fmaxf(mx, s[j]); }
            for (int o = 1; o < 64; o <<= 1) mx = fmaxf(mx, __shfl_xor(mx, o));
            float e[4], sm = 0.f;
#pragma unroll
            for (int j = 0; j < 4; ++j) { e[j] = (lane + 64 * j <= cmax) ? __builtin_amdgcn_exp2f(s[j] - mx) : 0.f; sm += e[j]; }
            sm = wave_sum(sm);
#pragma unroll
            for (int j = 0; j < 4; ++j) P[hp * 256 + lane + 64 * j] = sm > 0.f ? e[j] / fmaxf(sm, 1e-30f) : 0.f;
        }
        float imp = 0.f; { const int n = lane; for (int hp = 0; hp < 4; ++hp) for (int c = 4 * n - 1; c <= 4 * n + 3; ++c) if (c >= 0 && c <= 254) imp += P[hp * 256 + c]; }
        const bool valid = lane <= cur, forced = (lane == 0) || (lane == cur) || (lane == cur - 1);
        const float score = valid ? (forced ? 1e4f : imp) : -1e30f;
        sbuf[lane] = score;
        int rank = 0; for (int n2 = 0; n2 < 64; ++n2) { const float v2 = sbuf[n2]; rank += ((v2 > score) || (v2 == score && n2 < lane)) ? 1 : 0; }
        const bool sel = (rank < 16) && (score > -5e29f);
        const unsigned long long selmask = __ballot(sel);
        for (int hp = 0; hp < 4; ++hp) { const int head = 4 * g + hp;
            qbuf[lane] = bf2f(QO[rowg * D + head * 64 + lane]);
            float oc = 0.f; for (int c = 0; c <= cmax; ++c) oc += P[hp * 256 + c] * bf2f(VC[((size_t)bg * 256 + c) * 64 + lane]);
            float outv = GT[rowg * 48 + head * 3 + 0] * oc;
            for (int br = 1; br < 3; ++br) {
                const bf16* kb = KVB + (size_t)b * SEQ * NKV + (br == 1 ? 512 : 1024) + g * 64; const bf16* vb = kb + 256;
                float m = -INFINITY, l = 0.f, o = 0.f;
                const int k0 = br == 1 ? 0 : (t - 511 > 0 ? t - 511 : 0);
                for (int ks = k0; ks <= t; ks += 64) {
                    if (br == 1 && !((selmask >> (ks >> 6)) & 1ull)) continue;
                    const int kpos = ks + lane; float s = -INFINITY;
                    if (kpos <= t) { float acc = 0.f; for (int d = 0; d < 64; ++d) acc += qbuf[d] * bf2f(kb[(size_t)kpos * NKV + d]); s = acc; }
                    float mt = s; for (int o2 = 1; o2 < 64; o2 <<= 1) mt = fmaxf(mt, __shfl_xor(mt, o2));
                    const float mn = fmaxf(m, mt), al = __builtin_amdgcn_exp2f(m - mn); const float pe = (kpos <= t) ? __builtin_amdgcn_exp2f(s - mn) : 0.f;
                    l = l * al + wave_sum(pe); pbuf[lane] = pe;
                    float acc = 0.f; for (int k = 0; k < 64; ++k) { const int kp = ks + k; if (kp <= t) acc += pbuf[k] * bf2f(vb[(size_t)kp * NKV + lane]); }
                    o = o * al + acc; m = mn;
                }
                outv += GT[rowg * 48 + head * 3 + br] * (o / l);
            }
            const float got = bf2f(OB[rowg * D + head * 64 + lane]); const float df = got - outv;
            chk_add(sums, 6, df * df, outv * outv);
        }
    }
}
#endif

enum PhaseKind { K_PRO = 0, K_PREP, K_POOLG, K_KVQ, K_CMP1, K_CMP2, K_ATT, K_WOUT, K_UP, K_DOWN, K_GATE, K_FINAL };
constexpr int NPHASES = 26;
#ifndef PH_MASK
#define PH_MASK 0xFFFF
#endif
#define PH_EN(k) (((PH_MASK) >> (k)) & 1)
#ifndef PROBE_KIND
#define PROBE_KIND -1
#endif
#ifndef PROBE_MULT
#define PROBE_MULT 4
#endif
__host__ __device__ __forceinline__ void decode_phase(int ph, int& kind, int& l) {
    if (ph == 0) { kind = K_PRO; l = 0; return; }
    if (ph >= 25) { kind = K_FINAL; l = 3; return; }
    int idx;
    if (ph < 6) { l = 0; idx = ph - 1; } else if (ph < 11) { l = 1; idx = ph - 6; } else if (ph < 19) { l = 2; idx = ph - 11; } else { l = 3; idx = ph - 19; }
    if (l < 2) { kind = idx == 0 ? K_PREP : idx == 1 ? K_POOLG : idx == 2 ? K_UP : idx == 3 ? K_DOWN : K_GATE; }
    else if (l == 2) { kind = idx == 0 ? K_KVQ : idx == 1 ? K_CMP1 : idx == 2 ? K_CMP2 : idx == 3 ? K_ATT : idx == 4 ? K_WOUT : idx == 5 ? K_UP : idx == 6 ? K_DOWN : K_GATE; }
    else { kind = idx == 0 ? K_KVQ : idx == 1 ? K_ATT : idx == 2 ? K_WOUT : idx == 3 ? K_UP : idx == 4 ? K_DOWN : K_GATE; }
}

struct CmpOrder {
    int c; const char* kvb; const char* wc1;
    __device__ __forceinline__ bool next(int i, pg8::Unit& u) const {
        if (i != 0 || c >= 32) return false;
        const int bg = c >> 1, which = c & 1, b = bg >> 2, g = bg & 3;
        u.pm = bg; u.pn = which; u.a = kvb + ((size_t)b * SEQ * NKV + which * 256 + g * 64) * 2; u.b = wc1 + (size_t)which * 256 * 2048 * 2; return true; }
    __device__ __forceinline__ void a_ready(const pg8::Unit&) const {}
    __device__ __forceinline__ void done(const pg8::Unit&) const {}
};

__global__ void __launch_bounds__(NWAVES * 64, 2) fwd_kernel(Args args) {
    extern __shared__ __attribute__((aligned(16))) unsigned char lds_raw[];
    LAS unsigned char* const lds0 = (LAS unsigned char*)lds_raw;
    volatile LAS unsigned* MISC = (volatile LAS unsigned*)(lds0 + MISC_OFF);
    const int wave_s = __builtin_amdgcn_readfirstlane((int)threadIdx.x >> 6);
    for (int u = threadIdx.x; u < (LDS_BYTES - LDSCTL_OFF) / 4; u += NWAVES * 64) ((LAS unsigned*)(lds0 + LDSCTL_OFF))[u] = 0u;
    __syncthreads();
    XcdBarrier bar; bar.bar = (unsigned*)((gu32*)(args.ws + WS_CTL) + CW_BAR); bar.x = 0; bar.st = nullptr;
    const int lo = args.ph_lo, hi = args.ph_hi;
    if (hi - lo > 1) bar = xcd_barrier_post((unsigned*)((gu32*)(args.ws + WS_CTL) + CW_BAR), MISC + 8);

    int ver = 0;
#define SSQ(v) ((float*)(ws + (((v) & 1) ? WS_SSQ1 : WS_SSQ0)))
    unsigned long long pr_acc = 0ull, pr_t0 = 0ull;
    for (int ph = 0; ph < hi; ++ph) {
        int kind, l; decode_phase(ph, kind, l);
        const bool run = ph >= lo;
        if (PROBE_KIND >= 0 && run && kind == PROBE_KIND) pr_t0 = __builtin_amdgcn_s_memrealtime();
        if (run) {
            int bx_l = blockIdx.x; asm volatile("" : "+s"(bx_l));
            unsigned char* ws = args.ws; asm volatile("" : "+s"(ws));
            const int G_l = gridDim.x, vcu_l = (G_l % 8 == 0) ? (bx_l % 8) * (G_l / 8) + bx_l / 8 : bx_l;
#define FRESH_TID(name) int name; { int z_ = 0; asm volatile("" : "+v"(z_)); name = wave_s * 64 + (int)__builtin_amdgcn_mbcnt_hi(~0u, __builtin_amdgcn_mbcnt_lo(~0u, (unsigned)z_)); }
#define MAKE_FRAME(F, t) Frame F; F.lds = lds0; F.tid = (t); F.lane = (t) & 63; F.wave = wave_s; F.G = G_l; F.vcu = vcu_l; F.ws = ws;
            const float* x_in = (const float*)args.in[0]; float* X = args.out;
            bf16* XB = (bf16*)(ws + WS_XB); bf16* XBG = (bf16*)(ws + WS_XBG); bf16* PP = (bf16*)(ws + WS_PP); bf16* HB = (bf16*)(ws + WS_H);
            bf16* KVB = (bf16*)(ws + WS_KVB); bf16* QO = (bf16*)(ws + WS_QO); bf16* UPOOL = (bf16*)(ws + WS_UPOOL);
            const int cblk = bx_l;
            if (PH_EN(K_PRO) && kind == K_PRO) { FRESH_TID(t_) MAKE_FRAME(F, t_) phase_prologue(F, args); }
            if (PH_EN(K_PREP) && kind == K_PREP) { FRESH_TID(t_) MAKE_FRAME(F, t_) phase_poolprep(F, l == 0 ? x_in : (const float*)X, SSQ(ver), (const float*)args.in[3] + l * D, UPOOL); }
            if (PH_EN(K_POOLG) && (kind == K_POOLG || kind == K_KVQ)) {
                pg8::Gemm g{PLE, PLE, 128, 128, 4};
                pg8::GridOrder S{64, 4, G_l, cblk, (const char*)(ws + WS_PB) + (size_t)l * M * PLE * 2, (const char*)(ws + WS_WPP) + (size_t)l * D * PLE * 2, (size_t)256 * PLE * 2, 0, (size_t)256 * PLE * 2, 1 << 30, 0};
                EpiPP E{PP};
                { FRESH_TID(t_)
                pg8::gemm_phase<EpiPP, pg8::GridOrder, true, true>(lds0, g, S, E, t_); }
            }
            if (PH_EN(K_KVQ) && kind == K_KVQ) {
                const int nN = (l == 2) ? 11 : 5;
                pg8::Gemm g{D, D, 128, 128, 16};
                pg8::GridOrder S{64, nN, G_l, cblk, (const char*)XBG, (const char*)(ws + (l == 2 ? WS_WKVQ2 : WS_WQ3)), (size_t)256 * D * 2, 0, (size_t)256 * D * 2, 1 << 30, 0};
                EpiKVQ E{SSQ(ver), (const float*)(ws + WS_ROPE), KVB, QO, (float*)(ws + WS_GATES), (l == 2) ? 6 : 0};
                { FRESH_TID(t_)
                pg8::gemm_phase<EpiKVQ, pg8::GridOrder, true, true>(lds0, g, S, E, t_); }
            }
            if (PH_EN(K_CMP1) && kind == K_CMP1) {
                pg8::Gemm g{16 * NKV, 2048, NKV * 2, 128, 32};
                CmpOrder S{cblk, (const char*)KVB, (const char*)(ws + WS_WC1)};
                EpiCMP E{(const float*)(ws + WS_CB1), (bf16*)(ws + WS_HID)};
                { FRESH_TID(t_)
                pg8::gemm_phase<EpiCMP, CmpOrder, true, true>(lds0, g, S, E, t_); }
            }
            if (PH_EN(K_CMP2) && kind == K_CMP2) { FRESH_TID(t_) MAKE_FRAME(F, t_) phase_cmp2(F, (const bf16*)(ws + WS_HID), (const float*)args.in[10], (const float*)args.in[13], (const float*)(ws + WS_ROPEC), (bf16*)(ws + WS_KC), (bf16*)(ws + WS_VC)); }
            if (PH_EN(K_ATT) && kind == K_ATT) {
                att::Tensors T{QO, KVB, (const bf16*)(ws + WS_KC), (const bf16*)(ws + WS_VC), (const float*)(ws + WS_GATES), MK_CHECK ? XB : QO};
                const int bgi = (vcu_l >> 4) & 15, s = vcu_l & 15;
                for (int i = 0; i < 4; ++i) { const int qb = (i == 0) ? s : (i == 1) ? 31 - s : (i == 2) ? 32 + s : 63 - s;
                    FRESH_TID(t_) att::unit(T, bgi >> 2, bgi & 3, qb, (LAS char*)lds0, t_); }
            }
            if (PH_EN(K_DOWN) && (kind == K_POOLG || kind == K_WOUT || kind == K_DOWN)) {
                pg8::Gemm g; pg8::GridOrder S; S.nM = 64; S.nN = 4; S.G = G_l; S.c = cblk; S.pm_div = 1 << 30; S.b_pm = 0;
                const float* xold = X;
                if (kind == K_POOLG) { g = pg8::Gemm{D, 256, 128, 128, 4}; S.A = (const char*)UPOOL; S.a_tile = (size_t)256 * D * 2; S.a_pn = 512; S.B = (const char*)(ws + WS_WPOOL) + (size_t)l * D * 256 * 2; S.b_tile = (size_t)256 * 256 * 2; if (l == 0) xold = x_in; }
                else if (kind == K_WOUT) { g = pg8::Gemm{D, D, 128, 128, 16}; S.A = (const char*)QO; S.a_tile = (size_t)256 * D * 2; S.a_pn = 0; S.B = (const char*)(ws + WS_WOUT) + (size_t)(l - 2) * D * D * 2; S.b_tile = (size_t)256 * D * 2; }
                else { g = pg8::Gemm{FF, FF, 128, 128, 44}; S.A = (const char*)HB; S.a_tile = (size_t)256 * FF * 2; S.a_pn = 0; S.B = (const char*)(ws + WS_WDN) + (size_t)l * D * FF * 2; S.b_tile = (size_t)256 * FF * 2; }
                EpiX<0> E{xold, X, XB, SSQ(ver + 1), nullptr, nullptr};
                { FRESH_TID(t_)
                pg8::gemm_phase<EpiX<0>, pg8::GridOrder, false, true>(lds0, g, S, E, t_); }
            }
            if (PH_EN(K_UP) && kind == K_UP) {
                pg8::Gemm g{D, D, 128, 128, 16};
                EpiUP E{SSQ(ver), (const float*)args.in[18] + (size_t)l * 3 * FF2, (const float*)args.in[19] + (size_t)l * FF2, HB};
                for (int i = 0;; ++i) {
                    int pm, pn; if (!pg8::tile_order(NUPM, 22, G_l, cblk, i, pm, pn)) break;
                    pg8::OneUnit S; S.valid = true; S.u.pm = pm; S.u.pn = pn;
                    S.u.a = (const char*)XB + ((long)UPM * pm - 2) * (long)(D * 2); S.u.b = (const char*)(ws + WS_WUP) + ((size_t)l * FF2 + (size_t)pn * 256) * D * 2;
                    { FRESH_TID(t_)
                    pg8::gemm_phase<EpiUP, pg8::OneUnit, false, true>(lds0, g, S, E, t_); }
                }
            }
            if (PH_EN(K_GATE) && kind == K_GATE) {
                pg8::Gemm g{D, D, 128, 128, 16};
                pg8::GridOrder S{64, 4, G_l, cblk, (const char*)XB, (const char*)(ws + WS_WG) + (size_t)l * D * D * 2, (size_t)256 * D * 2, 0, (size_t)256 * D * 2, 1 << 30, 0};
                EpiX<1> E{X, X, XBG, SSQ(ver + 1), SSQ(ver), PP};
                { FRESH_TID(t_)
                pg8::gemm_phase<EpiX<1>, pg8::GridOrder, false, true>(lds0, g, S, E, t_); }
            }
                        if (PH_EN(K_FINAL) && kind == K_FINAL) { FRESH_TID(t_) MAKE_FRAME(F, t_) phase_final(F, X, (const float*)args.in[24]); }
            if (ph + 1 < hi) { XcdBarrier b2 = bar; asm volatile("" : "+s"(b2.bar)); xcd_barrier(b2); }
        }
        if (PROBE_KIND >= 0 && run && kind == PROBE_KIND) pr_acc += __builtin_amdgcn_s_memrealtime() - pr_t0;
        if (kind == K_POOLG || kind == K_WOUT || kind == K_DOWN || kind == K_GATE) ++ver;
    }
    if (PROBE_KIND >= 0 && blockIdx.x == 0) { const unsigned long long te = __builtin_amdgcn_s_memrealtime(); while (__builtin_amdgcn_s_memrealtime() - te < (unsigned long long)PROBE_MULT * pr_acc) __builtin_amdgcn_s_sleep(32); }
}

#if MK_CHECK
__global__ void __launch_bounds__(512) check_kernel(Args args) {
    extern __shared__ __attribute__((aligned(16))) unsigned char lds_raw[];
    LAS unsigned char* const lds0 = (LAS unsigned char*)lds_raw;
    unsigned char* ws = args.ws; const int tid = threadIdx.x, lane = tid & 63, wave = tid >> 6, bx = blockIdx.x, G = gridDim.x;
    float* sums = (float*)(ws + WS_CTL) + CW_CHK;
    check_proj(args, ws, bx * 512 + tid, G * 512);
    check_cmp(args, ws, bx * 8 + wave, G * 8, lane);
    check_attn(ws, lds0, wave, bx * 8 + wave, G * 8, lane);
    __syncthreads();
    if (tid == 0) { __threadfence(); atomicAdd((unsigned*)(ws + WS_CTL) + CW_CHK + 64, 1u); while (__hip_atomic_load((unsigned*)(ws + WS_CTL) + CW_CHK + 64, __ATOMIC_RELAXED, __HIP_MEMORY_SCOPE_AGENT) < (unsigned)G) __builtin_amdgcn_s_sleep(8); __threadfence(); }
    __syncthreads();
    const float sd = __hip_atomic_load(sums + 2 * MK_CHECK_SEL, __ATOMIC_RELAXED, __HIP_MEMORY_SCOPE_AGENT), sr = __hip_atomic_load(sums + 2 * MK_CHECK_SEL + 1, __ATOMIC_RELAXED, __HIP_MEMORY_SCOPE_AGENT);
    const float cval = sr > 0.f ? 1e4f * sqrtf(sd / sr) : 7e7f;
    for (int i = bx * 512 + tid; i < M * D; i += G * 512) args.out[i] = cval;
}
#endif

extern "C" void kernel_launch(void* const* d_in, const int* in_sizes, int n_in, void* d_out, int out_size, void* d_ws, size_t ws_size, hipStream_t stream) {
    static int grid = 0;
    if (grid == 0) {
        if (n_in != 25 || out_size != M * D || ws_size < WS_END) { fprintf(stderr, "kernel_launch: unexpected shapes (n_in %d, out %d, ws %zu < %zu); nothing launched\n", n_in, out_size, ws_size, (size_t)WS_END); grid = -1; return; }
        int dev = 0, cus = 0, per_cu = 0;
        if (hipGetDevice(&dev) != hipSuccess || hipDeviceGetAttribute(&cus, hipDeviceAttributeMultiprocessorCount, dev) != hipSuccess) { grid = -1; return; }
        if (hipFuncSetAttribute((const void*)fwd_kernel, hipFuncAttributeMaxDynamicSharedMemorySize, LDS_BYTES) != hipSuccess) { fprintf(stderr, "kernel_launch: hipFuncSetAttribute failed\n"); grid = -1; return; }
        if (hipOccupancyMaxActiveBlocksPerMultiprocessor(&per_cu, (const void*)fwd_kernel, NWAVES * 64, LDS_BYTES) != hipSuccess || per_cu < 1) fprintf(stderr, "kernel_launch: occupancy query reports %d\n", per_cu);
        (void)hipGetLastError();
        grid = 256;
        if (cus != 256) fprintf(stderr, "kernel_launch: device has %d CUs, kernel is built for 256\n", cus);
    }
    if (grid < 0) return;
    if (hipMemsetAsync((char*)d_ws + WS_CTL, 0, CTL_ZERO_BYTES, stream) != hipSuccess) return;
    Args a{};
    for (int i = 0; i < 25; ++i) a.in[i] = d_in[i];
    a.out = (float*)d_out; a.ws = (unsigned char*)d_ws;
#if MK_PER_PHASE
    for (int ph = 0; ph < NPHASES; ++ph) { a.ph_lo = ph; a.ph_hi = ph + 1; hipLaunchKernelGGL(fwd_kernel, dim3(grid), dim3(NWAVES * 64), LDS_BYTES, stream, a); }
#elif MK_CHECK
    a.ph_lo = 0; a.ph_hi = 15;
    hipLaunchKernelGGL(fwd_kernel, dim3(grid), dim3(NWAVES * 64), LDS_BYTES, stream, a);
    hipLaunchKernelGGL(check_kernel, dim3(grid), dim3(512), 65536, stream, a);
#else
    a.ph_lo = 0; a.ph_hi = NPHASES;
    hipLaunchKernelGGL(fwd_kernel, dim3(grid), dim3(NWAVES * 64), LDS_BYTES, stream, a);
#endif
}
```
